# Optimizing an MI355X kernel written in HIP

```python
import jax, jax.numpy as jnp
from jax import lax
import numpy as np

D_MODEL = 2048
BATCH = 1
SEQ = 8192
DEPTH = 2

N_A_LAYERS = DEPTH // 2
N_B_LAYERS = DEPTH - N_A_LAYERS
HEAD_DIM = 128
ROT_DIM = HEAD_DIM // 4
ROPE_THETA = 500000.0
MEM_HEADS = 4
MEM_DIM = MEM_HEADS * HEAD_DIM
N_MEM = 256
CONV_CH = 3 * D_MODEL // 4
CONV_K = 3
NSA_HEADS = (D_MODEL - MEM_DIM) // HEAD_DIM
NSA_KV_GROUPS = 4
NSA_REP = NSA_HEADS // NSA_KV_GROUPS
KV_WIDTH = NSA_KV_GROUPS * HEAD_DIM
CMP_STRIDE = 16
CMP_BLOCK = 2 * CMP_STRIDE
SLC_BLOCK = 64
N_SELECT = 16
WINDOW = 512
Q_BLOCK = 128
D_FF = 256 * ((8 * D_MODEL // 3 + 255) // 256)
RMS_EPS = 1e-6

kernel_name = 'yoco_shortconv_nsa_macaron_hybrid'


def rms_norm(x, g):
    xf = x.astype(jnp.float32)
    y = xf * lax.rsqrt(jnp.mean(xf * xf, axis=-1, keepdims=True) + RMS_EPS)
    return (y * g.astype(jnp.float32)).astype(x.dtype)


def swiglu(x, w_gate, w_up, w_down):
    return (jax.nn.silu(x @ w_gate) * (x @ w_up)) @ w_down


def _heads(x, n):
    b, s, _ = x.shape
    return x.reshape(b, s, n, HEAD_DIM).transpose(0, 2, 1, 3)


def _merge(x):
    b, n, s, d = x.shape
    return x.transpose(0, 2, 1, 3).reshape(b, s, n * d)


def rotary(x, pos):
    half = ROT_DIM // 2
    inv = 1.0 / (ROPE_THETA ** (jnp.arange(half, dtype=jnp.float32) / half))
    ang = pos.astype(jnp.float32)[:, None, :, None] * inv
    cos = jnp.cos(ang).astype(x.dtype)
    sin = jnp.sin(ang).astype(x.dtype)
    x1 = x[..., :half]
    x2 = x[..., half:ROT_DIM]
    return jnp.concatenate([x1 * cos - x2 * sin, x2 * cos + x1 * sin, x[..., ROT_DIM:]], axis=-1)


def masked_softmax(s, mask):
    s = jnp.where(mask, s, -jnp.inf)
    m = jnp.max(s, axis=-1, keepdims=True)
    m = jnp.where(jnp.isfinite(m), m, 0.0)
    e = jnp.where(mask, jnp.exp(s - m), 0.0)
    d = jnp.sum(e, axis=-1, keepdims=True)
    return e / jnp.where(d > 0, d, 1.0)


def short_conv(u, w):
    return lax.conv_general_dilated(u, w[:, None, :], window_strides=(1,), padding=[(CONV_K - 1, 0)],
                                    dimension_numbers=('NWC', 'WIO', 'NWC'),
                                    feature_group_count=u.shape[-1])


def memory_attention(q_in, mem, mem_norm_g, w_mem_kv):
    kv = rms_norm(mem, mem_norm_g) @ w_mem_kv
    k, v = jnp.split(kv, 2, axis=-1)
    k = _heads(k, MEM_HEADS)
    v = _heads(v, MEM_HEADS)
    q = _heads(q_in, MEM_HEADS)
    s = jnp.einsum('bhqd,bhkd->bhqk', q, k).astype(jnp.float32) * (HEAD_DIM ** -0.5)
    p = jax.nn.softmax(s, axis=-1).astype(v.dtype)
    return _merge(jnp.einsum('bhqk,bhkd->bhqd', p, v))


def _compress(k, pos_emb, w1, w2):
    b, g, s, d = k.shape
    chunks = k.reshape(b, g, s // CMP_STRIDE, CMP_STRIDE, d)
    blocks = jnp.concatenate([chunks[:, :, :-1], chunks[:, :, 1:]], axis=3) + pos_emb
    flat = blocks.reshape(b, g, s // CMP_STRIDE - 1, CMP_BLOCK * d)
    return jax.nn.gelu(flat @ w1) @ w2


def _cmp_to_slc(n_cmp, n_slc):
    cs = jnp.arange(n_cmp)[:, None] * CMP_STRIDE
    ss = jnp.arange(n_slc)[None, :] * SLC_BLOCK
    ov = jnp.clip(jnp.minimum(cs + CMP_BLOCK, ss + SLC_BLOCK) - jnp.maximum(cs, ss), 0, None)
    return ov.astype(jnp.float32) / CMP_BLOCK


def shared_nsa_kv(h, positions, kv_norm, w_kv, cmp_pos_k, cmp_w1_k, cmp_w2_k, cmp_pos_v, cmp_w1_v, cmp_w2_v):
    u = rms_norm(h, kv_norm) @ w_kv
    kc, vc, ks, vs, kw, vw = [_heads(t, NSA_KV_GROUPS) for t in jnp.split(u, 6, axis=-1)]
    kc = _compress(rotary(kc, positions), cmp_pos_k, cmp_w1_k, cmp_w2_k)
    vc = _compress(vc, cmp_pos_v, cmp_w1_v, cmp_w2_v)
    return kc, vc, rotary(ks, positions), vs, rotary(kw, positions), vw


def nsa_attention(q, gates, kc, vc, ks, vs, kw, vw):
    b, n_h, s, d = q.shape
    g = NSA_KV_GROUPS
    n_cmp = kc.shape[2]
    n_slc = s // SLC_BLOCK
    n_sel = min(N_SELECT, n_slc)
    overlap = _cmp_to_slc(n_cmp, n_slc)
    ks_blk = ks.reshape(b, g, n_slc, SLC_BLOCK, d)
    vs_blk = vs.reshape(b, g, n_slc, SLC_BLOCK, d)
    pad = ((0, 0), (0, 0), (WINDOW, 0), (0, 0))
    kw_pad = jnp.pad(kw, pad)
    vw_pad = jnp.pad(vw, pad)
    cmp_end = jnp.arange(n_cmp) * CMP_STRIDE + CMP_BLOCK - 1
    blk_ids = jnp.arange(n_slc)
    b_idx = jnp.arange(b)[:, None, None, None]
    g_idx = jnp.arange(g)[None, :, None, None]
    scale = HEAD_DIM ** -0.5

    def one_block(start):
        t = start + jnp.arange(Q_BLOCK)
        qb = lax.dynamic_slice_in_dim(q, start, Q_BLOCK, axis=2).reshape(b, g, NSA_REP, Q_BLOCK, d)
        gb = lax.dynamic_slice_in_dim(gates, start, Q_BLOCK, axis=2).reshape(b, g, NSA_REP, Q_BLOCK, 3)
        s_c = jnp.einsum('bgrqd,bgcd->bgrqc', qb, kc).astype(jnp.float32) * scale
        p_c = masked_softmax(s_c, cmp_end[None, :] <= t[:, None])
        o_c = jnp.einsum('bgrqc,bgcd->bgrqd', p_c.astype(vc.dtype), vc)
        imp = jnp.einsum('bgrqc,cs->bgqs', p_c, overlap)
        jt = (t // SLC_BLOCK)[:, None]
        valid = blk_ids[None, :] <= jt
        forced = (blk_ids[None, :] == 0) | (blk_ids[None, :] == jt) | (blk_ids[None, :] == jt - 1)
        score = jnp.where(forced, jnp.inf, jnp.where(valid, imp, -jnp.inf))
        _, idx = lax.top_k(score, n_sel)
        k_sel = ks_blk[b_idx, g_idx, idx]
        v_sel = vs_blk[b_idx, g_idx, idx]
        tok = idx[..., None] * SLC_BLOCK + jnp.arange(SLC_BLOCK)
        sel_mask = (tok <= t[:, None, None])[:, :, None].reshape(b, g, 1, Q_BLOCK, n_sel * SLC_BLOCK)
        s_s = jnp.einsum('bgrqd,bgqkld->bgrqkl', qb, k_sel).astype(jnp.float32) * scale
        p_s = masked_softmax(s_s.reshape(b, g, NSA_REP, Q_BLOCK, n_sel * SLC_BLOCK), sel_mask)
        p_s = p_s.reshape(b, g, NSA_REP, Q_BLOCK, n_sel, SLC_BLOCK).astype(v_sel.dtype)
        o_s = jnp.einsum('bgrqkl,bgqkld->bgrqd', p_s, v_sel)
        kwb = lax.dynamic_slice_in_dim(kw_pad, start, Q_BLOCK + WINDOW, axis=2)
        vwb = lax.dynamic_slice_in_dim(vw_pad, start, Q_BLOCK + WINDOW, axis=2)
        kt = start - WINDOW + jnp.arange(Q_BLOCK + WINDOW)
        wmask = (kt[None, :] >= 0) & (kt[None, :] <= t[:, None]) & (kt[None, :] > t[:, None] - WINDOW)
        s_w = jnp.einsum('bgrqd,bgkd->bgrqk', qb, kwb).astype(jnp.float32) * scale
        p_w = masked_softmax(s_w, wmask).astype(vwb.dtype)
        o_w = jnp.einsum('bgrqk,bgkd->bgrqd', p_w, vwb)
        o = gb[..., 0:1] * o_c + gb[..., 1:2] * o_s + gb[..., 2:3] * o_w
        return o.reshape(b, n_h, Q_BLOCK, d)

    starts = jnp.arange(s // Q_BLOCK, dtype=jnp.int32) * Q_BLOCK
    out = lax.map(one_block, starts)
    return out.transpose(1, 0, 3, 2, 4).reshape(b, s, n_h * d)


def setup_inputs(seed: int = 0) -> dict:
    key = jax.random.key(seed)
    k = jax.random.split(key, 26)

    def nrm(kk, shape, fan_in):
        return jax.random.normal(kk, shape, jnp.float32) * fan_in ** -0.5

    def gain(kk, shape):
        return 1.0 + 0.05 * jax.random.normal(kk, shape, jnp.float32)

    offset = jax.random.randint(k[2], (BATCH, 1), 0, 1024, dtype=jnp.int32)
    return {
        'x': jax.random.normal(k[0], (BATCH, SEQ, D_MODEL), jnp.float32),
        'mem': jax.random.normal(k[1], (BATCH, N_MEM, D_MODEL), jnp.float32),
        'positions': offset + jnp.arange(SEQ, dtype=jnp.int32)[None, :],
        'ffn_norm': gain(k[3], (DEPTH, 2, D_MODEL)),
        'ffn_w_gate': nrm(k[4], (DEPTH, 2, D_MODEL, D_FF), D_MODEL),
        'ffn_w_up': nrm(k[5], (DEPTH, 2, D_MODEL, D_FF), D_MODEL),
        'ffn_w_down': nrm(k[6], (DEPTH, 2, D_FF, D_MODEL), D_FF),
        'mix_norm': gain(k[7], (DEPTH, D_MODEL)),
        'mem_norm': gain(k[8], (DEPTH, D_MODEL)),
        'w_mem_kv': nrm(k[9], (DEPTH, D_MODEL, 2 * MEM_DIM), D_MODEL),
        'w_out': nrm(k[10], (DEPTH, D_MODEL, D_MODEL), D_MODEL),
        'w_in_conv': nrm(k[11], (N_A_LAYERS, D_MODEL, 3 * CONV_CH + MEM_DIM), D_MODEL),
        'conv_w': nrm(k[12], (N_A_LAYERS, CONV_K, CONV_CH), CONV_K),
        'w_in_nsa': nrm(k[13], (N_B_LAYERS, D_MODEL, NSA_HEADS * HEAD_DIM + 3 * NSA_HEADS + MEM_DIM), D_MODEL),
        'kv_norm': gain(k[14], (D_MODEL,)),
        'w_kv': nrm(k[15], (D_MODEL, 6 * KV_WIDTH), D_MODEL),
        'cmp_pos_k': 0.02 * jax.random.normal(k[16], (CMP_BLOCK, HEAD_DIM), jnp.float32),
        'cmp_w1_k': nrm(k[17], (CMP_BLOCK * HEAD_DIM, HEAD_DIM), CMP_BLOCK * HEAD_DIM),
        'cmp_w2_k': nrm(k[18], (HEAD_DIM, HEAD_DIM), HEAD_DIM),
        'cmp_pos_v': 0.02 * jax.random.normal(k[19], (CMP_BLOCK, HEAD_DIM), jnp.float32),
        'cmp_w1_v': nrm(k[20], (CMP_BLOCK * HEAD_DIM, HEAD_DIM), CMP_BLOCK * HEAD_DIM),
        'cmp_w2_v': nrm(k[21], (HEAD_DIM, HEAD_DIM), HEAD_DIM),
        'final_norm': gain(k[22], (D_MODEL,)),
    }


def reference(x, mem, positions, ffn_norm, ffn_w_gate, ffn_w_up, ffn_w_down, mix_norm, mem_norm, w_mem_kv,
              w_out, w_in_conv, conv_w, w_in_nsa, kv_norm, w_kv, cmp_pos_k, cmp_w1_k, cmp_w2_k,
              cmp_pos_v, cmp_w1_v, cmp_w2_v, final_norm):
    b, s, _ = x.shape
    h = x
    kv = None
    for layer in range(DEPTH):
        if layer == N_A_LAYERS:
            kv = shared_nsa_kv(h, positions, kv_norm, w_kv, cmp_pos_k, cmp_w1_k, cmp_w2_k,
                               cmp_pos_v, cmp_w1_v, cmp_w2_v)
        h = h + 0.5 * swiglu(rms_norm(h, ffn_norm[layer, 0]), ffn_w_gate[layer, 0],
                             ffn_w_up[layer, 0], ffn_w_down[layer, 0])
        hn = rms_norm(h, mix_norm[layer])
        if layer < N_A_LAYERS:
            u = hn @ w_in_conv[layer]
            gate_b, gate_c, hv, q_mem = jnp.split(u, [CONV_CH, 2 * CONV_CH, 3 * CONV_CH], axis=-1)
            tok = gate_b * short_conv(gate_c * hv, conv_w[layer])
        else:
            j = layer - N_A_LAYERS
            u = hn @ w_in_nsa[j]
            qd = NSA_HEADS * HEAD_DIM
            q_nsa, gate_logits, q_mem = jnp.split(u, [qd, qd + 3 * NSA_HEADS], axis=-1)
            q = rotary(_heads(q_nsa, NSA_HEADS), positions)
            gates = jax.nn.sigmoid(gate_logits.reshape(b, s, NSA_HEADS, 3)).transpose(0, 2, 1, 3)
            tok = nsa_attention(q, gates, *kv)
        mem_o = memory_attention(q_mem, mem, mem_norm[layer], w_mem_kv[layer])
        h = h + jnp.concatenate([tok, mem_o], axis=-1) @ w_out[layer]
        h = h + 0.5 * swiglu(rms_norm(h, ffn_norm[layer, 1]), ffn_w_gate[layer, 1],
                             ffn_w_up[layer, 1], ffn_w_down[layer, 1])
    return rms_norm(h, final_norm)
```

```cpp
#include <hip/hip_runtime.h>
#include <hip/hip_cooperative_groups.h>
#include <cstdio>
#include <cstdint>
namespace cg = cooperative_groups;
namespace pg8 {
#define PG8_LAS __attribute__((address_space(3)))
typedef unsigned short bf16_t;
typedef short bf16x8 __attribute__((ext_vector_type(8)));
typedef float f32x4 __attribute__((ext_vector_type(4)));
typedef unsigned u32x4 __attribute__((ext_vector_type(4)));
constexpr int BM = 256, BK = 64, HALF = 128, HTB = HALF * BK * 2  , STAGE_BYTES = 8 * HTB, NXCD = 8, WGM = 8;

__host__ __device__ __forceinline__ int lds_byte(int r, int c) { const int st = (r >> 4) * 2 + (c >> 5), rr = r & 15, cc = c & 31, ob = rr * 64 + cc * 2; return st * 1024 + (ob ^ (((ob >> 9) & 1) << 5)); }
__host__ __device__ __forceinline__ void stage_rc(int b, int& R, int& C) { const int st = b / 1024, sb = b % 1024, swz = sb ^ (((sb >> 9) & 1) << 5); R = (st >> 1) * 16 + swz / 64; C = (st & 1) * 32 + (swz % 64) / 2; }
__host__ __device__ __forceinline__ int perm32(int rho) { const int n = rho >> 4, i = rho & 15; return 8 * (i >> 2) + 4 * n + (i & 3); }

struct Unit { int pm, pn; };
struct Gemm { const bf16_t* A; const bf16_t* Bt; int M, N, K; };

struct StaticOrder {
    int nM, nN, nwg, G, c;
    __host__ __device__ void init(int M, int N, int G_, int c_) { nM = M / BM; nN = N / BM; nwg = nM * nN; G = G_; c = c_; }
    __host__ __device__ bool next(int i, Unit& u) const {
        const long L = (long)i * G + c; if (L >= nwg) return false;
        int wgid = (int)L; { const int q = nwg / NXCD, r = nwg % NXCD, xcd = wgid % NXCD, off = wgid / NXCD; wgid = (xcd < r ? xcd * (q + 1) : r * (q + 1) + (xcd - r) * q) + off; }
        const int nig = WGM * nN, gid = wgid / nig, fm = gid * WGM, gsz = (nM - fm) < WGM ? (nM - fm) : WGM;
        u.pm = fm + ((wgid % nig) % gsz); u.pn = (wgid % nig) / gsz; return true;
    }
    __device__ __forceinline__ void a_ready(const Unit&) const {}
    __device__ __forceinline__ void done(const Unit&) const {}
};

__device__ __forceinline__ unsigned cvt_pk_bf16(float lo, float hi) { unsigned r; asm volatile("v_cvt_pk_bf16_f32 %0, %1, %2" : "=v"(r) : "v"(lo), "v"(hi)); return r; }
typedef float f32x2 __attribute__((ext_vector_type(2)));
template <class Epi, class Sched, bool ALIGN_EPI = false, bool SP2 = false>
__device__ __forceinline__ void gemm_phase(PG8_LAS unsigned char* lds, const Gemm g, const Sched& S, const Epi& E) {
    const int tid = threadIdx.x, wid = __builtin_amdgcn_readfirstlane(tid >> 6), lane = tid & 63, wr = wid >> 2, wc = wid & 3, fr = lane & 15, fq = lane >> 4;
    const int K = g.K, nt = K / BK;
    unsigned voffA[2], voffB[2];
#pragma unroll
    for (int i = 0; i < 2; ++i) { int R, C; stage_rc(tid * 16 + i * 8192, R, C); const int Rb = Epi::PERM ? ((R & ~31) + perm32(R & 31)) : R;
        voffA[i] = (unsigned)(R * K + C) * 2u; voffB[i] = (unsigned)(Rb * K + C) * 2u; }
    const size_t kstep = (size_t)(BK * 2);
    const size_t hstep = (size_t)HALF * K * 2;
    const size_t tstep = 2 * hstep;
    const unsigned ldsw = (unsigned)wid * 1024u;
    const int aoff = lds_byte(wr * 64 + fr, fq * 8), boff = lds_byte(wc * 32 + fr, fq * 8);
#define PG8_SA(b, h) (((b) * 2 + (h)) * HTB)
#define PG8_SB(b, h) ((4 + (b) * 2 + (h)) * HTB)
#define PG8_STAGE(bufoff, gbase, voff) do { _Pragma("unroll") for (int _i = 0; _i < 2; ++_i) \
        __builtin_amdgcn_global_load_lds((const unsigned*)((const char*)(gbase) + (voff)[_i]), (PG8_LAS unsigned*)(lds + (bufoff) + ldsw + _i * 8192), 16, 0, 0); } while (0)
#define PG8_LDA(dst, b, h) do { _Pragma("unroll") for (int m = 0; m < 4; ++m) _Pragma("unroll") for (int k = 0; k < 2; ++k) dst[m][k] = *(const PG8_LAS bf16x8*)(lds + PG8_SA(b, h) + aoff + m * 2048 + k * 1024); } while (0)
#define PG8_LDB(dst, b, h) do { _Pragma("unroll") for (int n = 0; n < 2; ++n) _Pragma("unroll") for (int k = 0; k < 2; ++k) dst[n][k] = *(const PG8_LAS bf16x8*)(lds + PG8_SB(b, h) + boff + n * 2048 + k * 1024); } while (0)
#define PG8_MMA(ai, bj, At, Bt) do { __builtin_amdgcn_s_setprio(1); _Pragma("unroll") for (int m = 0; m < 4; ++m) _Pragma("unroll") for (int n = 0; n < 2; ++n) _Pragma("unroll") for (int k = 0; k < 2; ++k) \
        acc[ai][bj][m][n] = __builtin_amdgcn_mfma_f32_16x16x32_bf16(Bt[n][k], At[m][k], acc[ai][bj][m][n], 0, 0, 0); __builtin_amdgcn_s_setprio(0); } while (0)
#define PG8_WAIT_V(n) asm volatile("s_waitcnt vmcnt(" #n ")" ::: "memory")
#define PG8_WAIT_L(n) asm volatile("s_waitcnt lgkmcnt(" #n ")" ::: "memory")
#define PG8_BAR __builtin_amdgcn_s_barrier()
#define PG8_SCHED __builtin_amdgcn_sched_barrier(0)
    Unit cur, nxt; int ui = 0;
    if (!S.next(0, cur)) return;
    f32x4 acc[2][2][4][2];
#pragma unroll
    for (int a = 0; a < 2; ++a)
#pragma unroll
        for (int b = 0; b < 2; ++b)
#pragma unroll
            for (int m = 0; m < 4; ++m)
#pragma unroll
                for (int n = 0; n < 2; ++n) acc[a][b][m][n] = (f32x4){0.f, 0.f, 0.f, 0.f};
    bf16x8 At[4][2], B0[2][2], B1[2][2];
    const char* cA = (const char*)g.A + (size_t)cur.pm * tstep; const char* cB = (const char*)g.Bt + (size_t)cur.pn * tstep;
    S.a_ready(cur);
    if constexpr (SP2) {
        PG8_STAGE(PG8_SB(0, 0), cB, voffB); PG8_STAGE(PG8_SB(0, 1), cB + hstep, voffB); PG8_STAGE(PG8_SA(0, 0), cA, voffA); PG8_STAGE(PG8_SA(0, 1), cA + hstep, voffA);
        if (wr == 1) PG8_BAR;
        PG8_WAIT_V(2); PG8_BAR;
        PG8_STAGE(PG8_SB(1, 0), cB + kstep, voffB); PG8_STAGE(PG8_SA(1, 0), cA + kstep, voffA); PG8_STAGE(PG8_SB(1, 1), cB + hstep + kstep, voffB);
        PG8_WAIT_V(6); PG8_BAR;
    } else {
        PG8_STAGE(PG8_SB(0, 0), cB, voffB); PG8_STAGE(PG8_SA(0, 0), cA, voffA); PG8_STAGE(PG8_SB(0, 1), cB + hstep, voffB); PG8_STAGE(PG8_SA(0, 1), cA + hstep, voffA);
        if (wr == 1) PG8_BAR;
        PG8_WAIT_V(4); PG8_BAR;
        PG8_STAGE(PG8_SB(1, 0), cB + kstep, voffB); PG8_STAGE(PG8_SA(1, 0), cA + kstep, voffA); PG8_STAGE(PG8_SB(1, 1), cB + hstep + kstep, voffB);
        PG8_WAIT_V(6); PG8_BAR;
    }
    for (;;) {
        const bool has_next = S.next(ui + 1, nxt);
        const char* nA = has_next ? (const char*)g.A + (size_t)nxt.pm * tstep : cA; const char* nB = has_next ? (const char*)g.Bt + (size_t)nxt.pn * tstep : cB;
        for (int t = 0; t < nt; t += 2) {
            const bool last = (t == nt - 2);
            const char* a1 = cA + (size_t)(t + 1) * kstep;
            const char* a2 = last ? nA : cA + (size_t)(t + 2) * kstep; const char* b2 = last ? nB : cB + (size_t)(t + 2) * kstep;
            const char* a3 = a2 + kstep; const char* b3 = b2 + kstep;
            if (last && has_next) S.a_ready(nxt);
            if constexpr (SP2) {
            PG8_LDB(B0, 0, 0); PG8_LDB(B1, 0, 1); PG8_SCHED; PG8_LDA(At, 0, 0); PG8_STAGE(PG8_SA(1, 1), a1 + hstep, voffA);
            PG8_WAIT_V(8); PG8_WAIT_L(0); PG8_BAR; PG8_MMA(0, 0, At, B0); PG8_MMA(0, 1, At, B1); PG8_BAR; PG8_SCHED;
            PG8_LDA(At, 0, 1); PG8_STAGE(PG8_SB(0, 0), b2, voffB); PG8_STAGE(PG8_SB(0, 1), b2 + hstep, voffB); PG8_STAGE(PG8_SA(0, 0), a2, voffA);
            PG8_WAIT_V(8); PG8_WAIT_L(0); PG8_BAR; PG8_MMA(1, 0, At, B0); PG8_MMA(1, 1, At, B1); PG8_BAR; PG8_SCHED;
            PG8_LDB(B0, 1, 0); PG8_LDB(B1, 1, 1); PG8_SCHED; PG8_LDA(At, 1, 0); PG8_STAGE(PG8_SA(0, 1), a2 + hstep, voffA);
            PG8_WAIT_V(8); PG8_WAIT_L(0); PG8_BAR; PG8_MMA(0, 0, At, B0); PG8_MMA(0, 1, At, B1); PG8_BAR; PG8_SCHED;
            PG8_LDA(At, 1, 1); PG8_STAGE(PG8_SB(1, 0), b3, voffB); PG8_STAGE(PG8_SB(1, 1), b3 + hstep, voffB); PG8_STAGE(PG8_SA(1, 0), a3, voffA);
            PG8_WAIT_V(8); PG8_WAIT_L(0); PG8_BAR; PG8_MMA(1, 0, At, B0); PG8_MMA(1, 1, At, B1); PG8_BAR; PG8_SCHED;
            } else {
            PG8_LDB(B0, 0, 0); PG8_SCHED; PG8_LDA(At, 0, 0); PG8_STAGE(PG8_SA(1, 1), a1 + hstep, voffA);
            PG8_WAIT_L(8); PG8_BAR; PG8_WAIT_L(0); PG8_MMA(0, 0, At, B0); PG8_BAR; PG8_SCHED;
            PG8_LDB(B1, 0, 1); PG8_STAGE(PG8_SB(0, 0), b2, voffB);
            PG8_BAR; PG8_WAIT_L(0); PG8_MMA(0, 1, At, B1); PG8_BAR;
            PG8_LDA(At, 0, 1); PG8_STAGE(PG8_SA(0, 0), a2, voffA);
            PG8_BAR; PG8_WAIT_L(0); PG8_MMA(1, 0, At, B0); PG8_BAR; PG8_SCHED;
            PG8_STAGE(PG8_SB(0, 1), b2 + hstep, voffB);
            PG8_WAIT_V(6); PG8_BAR; PG8_MMA(1, 1, At, B1); PG8_BAR;
            PG8_LDB(B0, 1, 0); PG8_SCHED; PG8_LDA(At, 1, 0); PG8_STAGE(PG8_SA(0, 1), a2 + hstep, voffA);
            PG8_WAIT_L(8); PG8_BAR; PG8_WAIT_L(0); PG8_MMA(0, 0, At, B0); PG8_BAR; PG8_SCHED;
            PG8_LDB(B1, 1, 1); PG8_STAGE(PG8_SB(1, 0), b3, voffB);
            PG8_BAR; PG8_WAIT_L(0); PG8_MMA(0, 1, At, B1); PG8_BAR;
            PG8_LDA(At, 1, 1); PG8_STAGE(PG8_SA(1, 0), a3, voffA);
            PG8_BAR; PG8_WAIT_L(0); PG8_MMA(1, 0, At, B0); PG8_BAR; PG8_SCHED;
            PG8_STAGE(PG8_SB(1, 1), b3 + hstep, voffB);
            PG8_WAIT_V(6); PG8_BAR; PG8_MMA(1, 1, At, B1); PG8_BAR;
            }
        }
        if constexpr (ALIGN_EPI) { if (wr == 0) PG8_BAR; }
        if constexpr (!Epi::AFTER_DRAIN) { E(acc, cur, wr, wc, fr, fq); S.done(cur); }
        if (!has_next) break;
#pragma unroll
        for (int a = 0; a < 2; ++a)
#pragma unroll
            for (int b = 0; b < 2; ++b)
#pragma unroll
                for (int m = 0; m < 4; ++m)
#pragma unroll
                    for (int n = 0; n < 2; ++n) acc[a][b][m][n] = (f32x4){0.f, 0.f, 0.f, 0.f};
        cur = nxt; cA = nA; cB = nB; ++ui;
        if constexpr (ALIGN_EPI) { if (wr == 1) PG8_BAR; }
    }
    PG8_WAIT_V(0);
    if constexpr (!ALIGN_EPI) { if (wr == 0) PG8_BAR; }
    PG8_BAR;
    if constexpr (Epi::AFTER_DRAIN) { E.fused(acc, cur, wr, wc, fr, fq, lds, wid, lane); S.done(cur); }
#undef PG8_SA
#undef PG8_SB
#undef PG8_STAGE
#undef PG8_LDA
#undef PG8_LDB
#undef PG8_MMA
#undef PG8_WAIT_V
#undef PG8_WAIT_L
#undef PG8_BAR
#undef PG8_SCHED
}
}

#define LAS __attribute__((address_space(3)))
typedef unsigned short bf16;
typedef short bf16x8 __attribute__((ext_vector_type(8)));
typedef short s16x4 __attribute__((ext_vector_type(4)));
typedef float f32x4 __attribute__((ext_vector_type(4)));
typedef unsigned u32x4 __attribute__((ext_vector_type(4)));
typedef unsigned u32x2 __attribute__((ext_vector_type(2)));
using pg8::cvt_pk_bf16;

#ifndef MULTI_LAUNCH
#define MULTI_LAUNCH 0
#endif

constexpr int S = 8192, D = 2048, FF = 5632, NGU = 2 * FF, NCONV = 5120, NNSA = 2304, NNSA_SRC = 2084, NKV = 3072, CONVC = 1536;
constexpr int NMEM = 256, MEMKVW = 1024, QW = 1536;
constexpr int NTHREADS = 512, NWAVES = 8, LDS_BYTES = 131072 + 2048 + 256;
constexpr int NPHASES = 22;

constexpr size_t al256(size_t x) { return (x + 255) & ~(size_t)255; }
constexpr size_t SZ_WGU = (size_t)NGU * D * 2, SZ_WD = (size_t)D * FF * 2;
constexpr size_t WS_WGU = 0;
constexpr size_t WS_WD = WS_WGU + 4 * SZ_WGU;
constexpr size_t WS_WCONV = WS_WD + 4 * SZ_WD;
constexpr size_t WS_WNSA = WS_WCONV + (size_t)NCONV * D * 2;
constexpr size_t WS_WOUT = WS_WNSA + (size_t)NNSA * D * 2;
constexpr size_t WS_WKV = WS_WOUT + 2 * (size_t)D * D * 2;
constexpr size_t WS_WMEM = WS_WKV + (size_t)NKV * D * 2;
constexpr size_t WS_W1C = WS_WMEM + 2 * (size_t)MEMKVW * D * 2;
constexpr size_t WS_W2C = WS_W1C + 2 * (size_t)128 * 4096 * 2;
constexpr size_t WS_H = WS_W2C + 2 * (size_t)128 * 128 * 2;
constexpr size_t WS_XN = WS_H + (size_t)S * D * 4;
constexpr size_t WS_XKV = WS_XN + (size_t)S * D * 2;
constexpr size_t WS_ACT = WS_XKV + (size_t)S * D * 2;
constexpr size_t WS_UCONV = WS_ACT;
constexpr size_t WS_UNSA = WS_ACT;
constexpr size_t WS_TMP = WS_ACT + (size_t)S * NNSA * 2;
constexpr size_t WS_UKV = WS_ACT + (size_t)S * FF * 2;
constexpr size_t WS_CAT = WS_UKV + (size_t)S * NKV * 2;
constexpr size_t WS_KCR = WS_CAT + (size_t)S * D * 2;
constexpr size_t SZ_KR = (size_t)4 * S * 128 * 2, SLACK = 16 * 128 * 2;
constexpr size_t WS_VCR = WS_KCR + SZ_KR + SLACK;
constexpr size_t WS_KSR = WS_VCR + SZ_KR + SLACK;
constexpr size_t WS_KWR = WS_KSR + SZ_KR;
constexpr size_t WS_KCC = WS_KWR + SZ_KR;
constexpr size_t WS_VCC = WS_KCC + (size_t)4 * 512 * 128 * 2;
constexpr size_t WS_MEMN = WS_VCC + (size_t)4 * 512 * 128 * 2;
constexpr size_t WS_MEMKV = WS_MEMN + 2 * (size_t)NMEM * D * 2;
constexpr size_t WS_ROPE = WS_MEMKV + 2 * (size_t)NMEM * MEMKVW * 2;
constexpr size_t WS_SELB = WS_ROPE + (size_t)S * 32 * 4;
constexpr size_t WS_SS = WS_SELB + (size_t)S * 4 * 4 * 4;
constexpr size_t WS_CTL = WS_SS + (size_t)5 * S * 4;
constexpr size_t CTL_BYTES = 16384;
constexpr size_t WS_END = WS_CTL + CTL_BYTES;
static_assert((size_t)S * NNSA * 2 + (size_t)S * QW * 4 <= (size_t)S * FF * 2, "overlay fits in ACT");
static_assert((size_t)S * NCONV * 2 <= (size_t)S * FF * 2, "overlay fits in ACT");
static_assert(WS_END <= (size_t)4 * 2 * 2 * 2048 * 5632 * 4, "workspace must fit the guaranteed size");

struct Args { const void* in[23]; float* out; unsigned char* ws; int ph_lo, ph_hi; };

struct Ctx { LAS unsigned char* lds; int tid, lane, wid, G, bid; };

__device__ __forceinline__ float bf2f(unsigned short b) { return __uint_as_float(((unsigned)b) << 16); }
__device__ __forceinline__ float bflo(unsigned w) { return __uint_as_float(w << 16); }
__device__ __forceinline__ float bfhi(unsigned w) { return __uint_as_float(w & 0xffff0000u); }
__device__ __forceinline__ float wave_sum(float v) {
#pragma unroll
    for (int o = 1; o < 64; o <<= 1) v += __shfl_xor(v, o);
    return v;
}
__device__ __forceinline__ float fexp2(float x) { return __builtin_amdgcn_exp2f(x); }

__device__ __forceinline__ float rstd_of(const float* ss, int row) { return ss ? 1.0f / sqrtf(ss[row] * (1.0f / D) + 1e-6f) : 1.0f; }
struct EpiPlain {
    static constexpr bool PERM = true, AFTER_DRAIN = false;
    bf16* O; int ldc; const float* ss = nullptr;
    __device__ __forceinline__ void operator()(const f32x4 (&acc)[2][2][4][2], const pg8::Unit& u, int wr, int wc, int fr, int fq) const {
        const int row0 = u.pm * 256 + wr * 64 + fr, col0 = u.pn * 256 + wc * 32 + 8 * fq;
#pragma unroll
        for (int ai = 0; ai < 2; ++ai)
#pragma unroll
            for (int m = 0; m < 4; ++m) { const int row = row0 + ai * 128 + m * 16; bf16* rowp = O + (size_t)row * ldc + col0; const float rs = rstd_of(ss, row);
#pragma unroll
                for (int bj = 0; bj < 2; ++bj) { const f32x4 v0 = acc[ai][bj][m][0] * rs, v1 = acc[ai][bj][m][1] * rs;
                    u32x4 w; w.x = cvt_pk_bf16(v0[0], v0[1]); w.y = cvt_pk_bf16(v0[2], v0[3]); w.z = cvt_pk_bf16(v1[0], v1[1]); w.w = cvt_pk_bf16(v1[2], v1[3]);
                    *(u32x4*)(rowp + bj * 128) = w; } }
    }
};
__device__ __forceinline__ float silu_mul(float g, float u) { return g * __builtin_amdgcn_rcpf(1.0f + fexp2(-1.4426950408889634f * g)) * u; }
struct EpiSwiGLU {
    static constexpr bool PERM = true, AFTER_DRAIN = false;
    bf16* O; int ldc; const float* ss = nullptr;
    __device__ __forceinline__ void operator()(const f32x4 (&acc)[2][2][4][2], const pg8::Unit& u, int wr, int wc, int fr, int fq) const {
        const int row0 = u.pm * 256 + wr * 64 + fr, col0 = u.pn * 128 + wc * 32 + 8 * fq;
#pragma unroll
        for (int ai = 0; ai < 2; ++ai)
#pragma unroll
            for (int m = 0; m < 4; ++m) { const int row = row0 + ai * 128 + m * 16; bf16* rowp = O + (size_t)row * ldc + col0; const float rs = rstd_of(ss, row);
                const f32x4 g0 = acc[ai][0][m][0] * rs, g1 = acc[ai][0][m][1] * rs, u0 = acc[ai][1][m][0] * rs, u1 = acc[ai][1][m][1] * rs;
                u32x4 w;
                w.x = cvt_pk_bf16(silu_mul(g0[0], u0[0]), silu_mul(g0[1], u0[1])); w.y = cvt_pk_bf16(silu_mul(g0[2], u0[2]), silu_mul(g0[3], u0[3]));
                w.z = cvt_pk_bf16(silu_mul(g1[0], u1[0]), silu_mul(g1[1], u1[1])); w.w = cvt_pk_bf16(silu_mul(g1[2], u1[2]), silu_mul(g1[3], u1[3]));
                *(u32x4*)rowp = w; }
    }
};
struct EpiRes {
    static constexpr bool PERM = false, AFTER_DRAIN = false;
    const float* base; float* out; int ldc; float alpha;
    float* ss = nullptr; bf16* o1 = nullptr;
    __device__ __forceinline__ void operator()(const f32x4 (&acc)[2][2][4][2], const pg8::Unit& u, int wr, int wc, int fr, int fq) const {
        const int row0 = u.pm * 256 + wr * 64 + fr, col0 = u.pn * 256 + wc * 32 + 4 * fq;
#pragma unroll
        for (int ai = 0; ai < 2; ++ai)
#pragma unroll
            for (int m = 0; m < 4; ++m) { const int row = row0 + ai * 128 + m * 16; const size_t off = (size_t)row * ldc + col0; float sq = 0.f;
#pragma unroll
                for (int bj = 0; bj < 2; ++bj)
#pragma unroll
                    for (int n = 0; n < 2; ++n) { const int co = bj * 128 + n * 16; const f32x4 b = *(const f32x4*)(base + off + co);
                        const f32x4 v = b + alpha * acc[ai][bj][m][n]; *(f32x4*)(out + off + co) = v;
                        if (ss) { sq += (v.x * v.x + v.y * v.y) + (v.z * v.z + v.w * v.w);
                            u32x2 w; w.x = cvt_pk_bf16(v.x, v.y); w.y = cvt_pk_bf16(v.z, v.w); *(u32x2*)(o1 + off + co) = w; } }
                if (ss) { sq += __shfl_xor(sq, 16); sq += __shfl_xor(sq, 32); if (fq == 0) atomicAdd(ss + row, sq); } }
    }
};

template <class Epi>
__device__ __forceinline__ void run_gemm(const Ctx& c, const bf16* A, const bf16* Bt, int M, int N, int K, const Epi& E, int cidx) {
    pg8::Gemm g{A, Bt, M, N, K}; pg8::StaticOrder So; So.init(M, N, c.G, cidx);
    pg8::gemm_phase<Epi, pg8::StaticOrder, true, true>(c.lds, g, So, E);
}

struct Seg { const float* src; bf16* dst; int K, N, c0, nc, d0, mode; const float* gk; };
constexpr int NSEG = 25;
__device__ __forceinline__ Seg get_seg(const Args& a, int id) {
    Seg s; unsigned char* ws = a.ws; s.c0 = 0; s.d0 = 0; s.mode = 0; s.gk = nullptr;
    if (id < 12) { const int f = id / 3, kind = id - 3 * f;
        if (kind == 0) { s.src = (const float*)a.in[4] + (size_t)f * D * FF; s.dst = (bf16*)(ws + WS_WGU + f * SZ_WGU); s.K = D; s.N = FF; s.nc = FF; s.mode = 1; if (f > 0) s.gk = (const float*)a.in[3] + (size_t)f * D; }
        else if (kind == 1) { s.src = (const float*)a.in[5] + (size_t)f * D * FF; s.dst = (bf16*)(ws + WS_WGU + f * SZ_WGU); s.K = D; s.N = FF; s.nc = FF; s.mode = 1; s.d0 = 128; if (f > 0) s.gk = (const float*)a.in[3] + (size_t)f * D; }
        else { s.src = (const float*)a.in[6] + (size_t)f * FF * D; s.dst = (bf16*)(ws + WS_WD + f * SZ_WD); s.K = FF; s.N = D; s.nc = D; }
    } else if (id == 12) { s.src = (const float*)a.in[11]; s.dst = (bf16*)(ws + WS_WCONV); s.K = D; s.N = NCONV; s.nc = NCONV; s.gk = (const float*)a.in[7]; }
    else if (id == 13) { s.src = (const float*)a.in[13]; s.dst = (bf16*)(ws + WS_WNSA); s.K = D; s.N = NNSA_SRC; s.c0 = 0; s.nc = 1536; s.d0 = 0; s.gk = (const float*)a.in[7] + D; }
    else if (id == 14) { s.src = (const float*)a.in[13]; s.dst = (bf16*)(ws + WS_WNSA); s.K = D; s.N = NNSA_SRC; s.c0 = 1536; s.nc = 36; s.d0 = 2048; s.gk = (const float*)a.in[7] + D; }
    else if (id == 15) { s.src = (const float*)a.in[13]; s.dst = (bf16*)(ws + WS_WNSA); s.K = D; s.N = NNSA_SRC; s.c0 = 1572; s.nc = 512; s.d0 = 1536; s.gk = (const float*)a.in[7] + D; }
    else if (id <= 17) { const int l = id - 16; s.src = (const float*)a.in[10] + (size_t)l * D * D; s.dst = (bf16*)(ws + WS_WOUT + (size_t)l * D * D * 2); s.K = D; s.N = D; s.nc = D; }
    else if (id == 18) { s.src = (const float*)a.in[15]; s.dst = (bf16*)(ws + WS_WKV); s.K = D; s.N = NKV; s.nc = NKV; s.gk = (const float*)a.in[14]; }
    else if (id <= 20) { const int l = id - 19; s.src = (const float*)a.in[9] + (size_t)l * D * MEMKVW; s.dst = (bf16*)(ws + WS_WMEM + (size_t)l * MEMKVW * D * 2); s.K = D; s.N = MEMKVW; s.nc = MEMKVW; }
    else if (id <= 22) { const int w = id - 21; s.src = (const float*)a.in[w ? 20 : 17]; s.dst = (bf16*)(ws + WS_W1C + (size_t)w * 128 * 4096 * 2); s.K = 4096; s.N = 128; s.nc = 128; }
    else { const int w = id - 23; s.src = (const float*)a.in[w ? 21 : 18]; s.dst = (bf16*)(ws + WS_W2C + (size_t)w * 128 * 128 * 2); s.K = 128; s.N = 128; s.nc = 128; }
    return s;
}
__device__ __forceinline__ void transpose_item(const Seg& s, LAS float* scr, int item, int lane) {
    const int nblk = (s.nc + 31) >> 5, kb = item / nblk, nb = item - kb * nblk, k0 = 64 * kb, cb = 32 * nb;
    const int cl = cb + (lane & 31); const bool cok = cl < s.nc;
    const float* sp = s.src + (size_t)(k0 + (lane >> 5)) * s.N + s.c0 + cl;
    float tv[32];
#pragma unroll
    for (int i = 0; i < 32; ++i) tv[i] = cok ? __builtin_nontemporal_load(sp + (size_t)(2 * i) * s.N) : 0.f;
    if (s.gk) {
#pragma unroll
        for (int i = 0; i < 32; ++i) tv[i] *= s.gk[k0 + 2 * i + (lane >> 5)];
    }
#pragma unroll
    for (int i = 0; i < 32; ++i) scr[(2 * i + (lane >> 5)) * 33 + (lane & 31)] = tv[i];
    asm volatile("s_waitcnt lgkmcnt(0)" ::: "memory");
    const int c8 = lane & 7;
#pragma unroll
    for (int j = 0; j < 4; ++j) { const int n = (lane >> 3) + 8 * j; const int c = cb + n; const LAS float* q = scr + (8 * c8) * 33 + n;
        u32x4 o; o.x = cvt_pk_bf16(q[0 * 33], q[1 * 33]); o.y = cvt_pk_bf16(q[2 * 33], q[3 * 33]); o.z = cvt_pk_bf16(q[4 * 33], q[5 * 33]); o.w = cvt_pk_bf16(q[6 * 33], q[7 * 33]);
        const int drow = s.d0 + (s.mode ? ((c >> 7) * 256 + (c & 127)) : c);
        if (c < s.nc) *(u32x4*)(s.dst + (size_t)drow * s.K + k0 + 8 * c8) = o; }
    asm volatile("s_waitcnt lgkmcnt(0)" ::: "memory");
}

__device__ __forceinline__ void rms_row(const float* xrow, const float* g1, bf16* o1, const float* g2, bf16* o2, float* of, int lane) {
    const f32x4* xr = (const f32x4*)xrow + lane;
    f32x4 v[8]; float s = 0.f;
#pragma unroll
    for (int j = 0; j < 8; ++j) { v[j] = xr[64 * j]; s += (v[j].x * v[j].x + v[j].y * v[j].y) + (v[j].z * v[j].z + v[j].w * v[j].w); }
    const float rstd = 1.0f / sqrtf(wave_sum(s) * (1.0f / D) + 1e-6f);
#pragma unroll
    for (int j = 0; j < 8; ++j) { const f32x4 y = v[j] * rstd; const f32x4 ga = ((const f32x4*)g1)[lane + 64 * j]; const f32x4 a = y * ga;
        if (o1) { u32x2 w; w.x = cvt_pk_bf16(a.x, a.y); w.y = cvt_pk_bf16(a.z, a.w); ((u32x2*)o1)[lane + 64 * j] = w; }
        if (of) ((f32x4*)of)[lane + 64 * j] = a;
        if (o2) { const f32x4 gb = ((const f32x4*)g2)[lane + 64 * j]; const f32x4 b = y * gb; u32x2 w; w.x = cvt_pk_bf16(b.x, b.y); w.y = cvt_pk_bf16(b.z, b.w); ((u32x2*)o2)[lane + 64 * j] = w; } }
}
__device__ __forceinline__ void norm_rows(const Ctx& c, const float* src, int nrows, const float* g1, bf16* o1, const float* g2, bf16* o2, float* of) {
    const int gw = c.bid * NWAVES + c.wid, NGW = c.G * NWAVES;
    for (int r = gw; r < nrows; r += NGW) rms_row(src + (size_t)r * D, g1, o1 ? o1 + (size_t)r * D : nullptr, g2, o2 ? o2 + (size_t)r * D : nullptr, of ? of + (size_t)r * D : nullptr, c.lane);
}

__device__ __forceinline__ void convert_segs(const Ctx& c, const Args& a, unsigned mask, int widx, int nwork) {
    LAS float* scr = (LAS float*)(c.lds + c.wid * 16384);
    const int gw = widx * NWAVES + c.wid, NGW = nwork * NWAVES;
    int base = 0;
    for (int sid = 0; sid < NSEG; ++sid) {
        if (!((mask >> sid) & 1u)) continue;
        const Seg s = get_seg(a, sid);
        const int n = (s.K >> 6) * ((s.nc + 31) >> 5);
        int first = (gw - base) % NGW; if (first < 0) first += NGW;
        for (int it = first; it < n; it += NGW) transpose_item(s, scr, it, c.lane);
        base = (base + n) % NGW;
    }
}
constexpr unsigned SEGM(int i) { return 1u << i; }
constexpr unsigned CV_ALL = (1u << NSEG) - 1u;
constexpr unsigned CV_P1 = SEGM(2) | SEGM(12);
constexpr unsigned CV_P4 = SEGM(16) | SEGM(3) | SEGM(4);
constexpr unsigned CV_P8 = SEGM(5) | SEGM(13) | SEGM(14) | SEGM(15) | SEGM(21) | SEGM(22) | SEGM(23) | SEGM(24) | SEGM(17);
constexpr unsigned CV_P14 = SEGM(9) | SEGM(10);
constexpr unsigned CV_P19 = SEGM(11);
constexpr unsigned CV_P0 = CV_ALL & ~(CV_P1 | CV_P4 | CV_P8 | CV_P14 | CV_P19);
__device__ __forceinline__ void prologue(const Ctx& c, const Args& a) {
    convert_segs(c, a, (c.G == 256) ? CV_P0 : CV_ALL, c.bid, c.G);
    const int gw = c.bid * NWAVES + c.wid, NGW = c.G * NWAVES;
    norm_rows(c, (const float*)a.in[0], S, (const float*)a.in[3], (bf16*)(a.ws + WS_XN), nullptr, nullptr, nullptr);
    norm_rows(c, (const float*)a.in[1], NMEM, (const float*)a.in[8], (bf16*)(a.ws + WS_MEMN), (const float*)a.in[8] + D, (bf16*)(a.ws + WS_MEMN + (size_t)NMEM * D * 2), nullptr);
    const int* pos = (const int*)a.in[2]; float* rope = (float*)(a.ws + WS_ROPE);
    for (int i = c.bid * NTHREADS + c.tid; i < S * 16; i += c.G * NTHREADS) { const int t = i >> 4, f = i & 15;
        const double inv = pow(500000.0, -(double)f / 16.0);
        const double ang = (double)pos[t] * inv; rope[t * 32 + f] = (float)cos(ang); rope[t * 32 + 16 + f] = (float)sin(ang); }
    for (int i = c.bid * NTHREADS + c.tid; i < 5 * S; i += c.G * NTHREADS) ((float*)(a.ws + WS_SS))[i] = 0.f;
    for (int i = c.bid * NTHREADS + c.tid; i < 2 * 2048; i += c.G * NTHREADS) { bf16* p = (bf16*)(a.ws + (i < 2048 ? WS_KCR : WS_VCR) + SZ_KR); p[i & 2047] = 0; }
}

typedef short v4i16_t __attribute__((ext_vector_type(4)));
__device__ __forceinline__ s16x4 vtr(LAS const unsigned char* p) { return __builtin_bit_cast(s16x4, __builtin_amdgcn_ds_read_tr16_b64_v4i16((LAS v4i16_t*)p)); }
__device__ __forceinline__ unsigned xr_of(unsigned row) { return ((row & 3u) << 2) | ((row >> 2) & 3u); }
constexpr int KV_BUF = 32768;
constexpr int IMP_OFF = 65536;
constexpr float C1 = 0.08838834764831845f * 1.4426950408889634f;

__device__ __forceinline__ void stage_kv(LAS unsigned char* buf, const bf16* Kg, int ldk, const bf16* Vg, int ldv, int key0, int wid, int lane_in) {
    int lane = lane_in; asm volatile("" : "+v"(lane));
#pragma unroll
    for (int i = 0; i < 2; ++i) {
        const unsigned b = (unsigned)(i * 8192 + wid * 1024 + lane * 16); const unsigned row = b >> 8, pos = (b >> 4) & 15u; const unsigned ch = pos ^ xr_of(row);
        const unsigned chv = pos ^ (2u * (row & 7u));
        __builtin_amdgcn_global_load_lds((const unsigned*)(Kg + (size_t)(key0 + (int)row) * ldk + ch * 8), (LAS unsigned*)(buf + i * 8192 + wid * 1024), 16, 0, 0);
        __builtin_amdgcn_global_load_lds((const unsigned*)(Vg + (size_t)(key0 + (int)row) * ldv + chv * 8), (LAS unsigned*)(buf + 16384 + i * 8192 + wid * 1024), 16, 0, 0);
    }
}

__device__ __forceinline__ float gmax4(float x) { auto a = __builtin_amdgcn_permlane16_swap(__float_as_uint(x), __float_as_uint(x), false, false); x = fmaxf(__uint_as_float(a[0]), __uint_as_float(a[1]));
    auto b = __builtin_amdgcn_permlane32_swap(__float_as_uint(x), __float_as_uint(x), false, false); return fmaxf(__uint_as_float(b[0]), __uint_as_float(b[1])); }
__device__ __forceinline__ float gsum4(float x) { auto a = __builtin_amdgcn_permlane16_swap(__float_as_uint(x), __float_as_uint(x), false, false); x = __uint_as_float(a[0]) + __uint_as_float(a[1]);
    auto b = __builtin_amdgcn_permlane32_swap(__float_as_uint(x), __float_as_uint(x), false, false); return __uint_as_float(b[0]) + __uint_as_float(b[1]); }
struct AX { float linv[3]; float tc; LAS float* impw; bool first; unsigned sel[4]; };

template <int NH, int MODE, bool EMASK, int QS>
__device__ __forceinline__ void attn_tile(LAS const unsigned char* kbuf, LAS const unsigned char* vbuf, const bf16x8 (&Q)[NH][4], f32x4 (&O)[NH][8], float (&m)[NH], float (&l)[NH],
                                          int key0, int T, int t, int lane_in, unsigned csel, AX& ax) {
    constexpr int HV = (NH > 1) ? 2 : 1, KBN = 4 / HV, CN = 2 / HV;
    int lane = lane_in; asm volatile("" : "+v"(lane));
    const int g = lane >> 4, r = lane & 15;
    const unsigned xr = xr_of((unsigned)r);
    const unsigned kbase = 256u * (unsigned)r + 16u * ((unsigned)g ^ (xr & 3u)), xs = xr >> 2;
    const unsigned q = (unsigned)r >> 2, pp = (unsigned)r & 3u;
    const unsigned wv = 4u * ((unsigned)g & 1u) + q;
    const unsigned vrow = 256u * (4u * (unsigned)g + q) + 8u * (pp & 1u) + 16u * (pp >> 1);
    const float NEG = -__builtin_inff();
    float prevc = ax.tc;
#pragma unroll
    for (int hf = 0; hf < HV; ++hf) {
        f32x4 sacc[NH][KBN];
#pragma unroll
        for (int h = 0; h < NH; ++h)
#pragma unroll
            for (int kbl = 0; kbl < KBN; ++kbl) sacc[h][kbl] = (f32x4){0.f, 0.f, 0.f, 0.f};
#pragma unroll
        for (int kbl = 0; kbl < KBN; ++kbl) {
            bf16x8 kf[4];
#pragma unroll
            for (int s = 0; s < 4; ++s) kf[s] = *(LAS const bf16x8*)(kbuf + kbase + 4096u * (hf * KBN + kbl) + 64u * ((unsigned)s ^ xs));
            __builtin_amdgcn_s_setprio(1);
#pragma unroll
            for (int s = 0; s < 4; ++s)
#pragma unroll
                for (int h = 0; h < NH; ++h) sacc[h][kbl] = __builtin_amdgcn_mfma_f32_16x16x32_bf16(kf[s], Q[h][s], sacc[h][kbl], 0, 0, 0);
            __builtin_amdgcn_s_setprio(0);
            if (NH > 1) __builtin_amdgcn_sched_barrier(0);
        }
        bf16x8 pk[NH][CN];
        float mainh[KBN], carh[KBN];
#pragma unroll
        for (int kbl = 0; kbl < KBN; ++kbl) { mainh[kbl] = 0.f; carh[kbl] = 0.f; }
#pragma unroll
        for (int h = 0; h < NH; ++h) {
            const int th = t + QS * h;
            int hi_lim = 1 << 20, lo_lim = -(1 << 20);
            if (MODE == 0 || MODE == 1) hi_lim = ((th - 31) >> 4) - key0 - 4 * g;
            if (MODE == 2 || MODE == 3) hi_lim = th - key0 - 4 * g;
            if (MODE == 3) lo_lim = th - 512 - key0 - 4 * g;
            const float bias = (MODE == 2 && !((csel >> h) & 1u)) ? NEG : 0.f;
            float x[KBN][4]; float mx = NEG;
#pragma unroll
            for (int kbl = 0; kbl < KBN; ++kbl)
#pragma unroll
                for (int i = 0; i < 4; ++i) {
                    float v = sacc[h][kbl][i];
                    if (EMASK) { const int e = 16 * (hf * KBN + kbl) + i; const bool valid = (MODE == 3) ? (e <= hi_lim && e > lo_lim) : (e <= hi_lim); v = valid ? v : NEG; }
                    x[kbl][i] = v; mx = fmaxf(mx, v);
                }
            float p[KBN][4];
            if (MODE == 1) {
                const float nmu = -m[h], li = ax.linv[h];
#pragma unroll
                for (int kbl = 0; kbl < KBN; ++kbl) {
#pragma unroll
                    for (int i = 0; i < 4; ++i) p[kbl][i] = fexp2(fmaf(x[kbl][i], C1, nmu)) * li;
                    mainh[kbl] += (p[kbl][0] + p[kbl][1]) + (p[kbl][2] + 0.5f * p[kbl][3]); carh[kbl] += 0.5f * p[kbl][3];
                }
            } else {
                mx = gmax4(mx);
                mx = mx * C1 + bias;
                const float mn = fmaxf(m[h], mx); const float mu = (mn == NEG) ? 0.f : mn;
                const float alpha = fexp2(m[h] - mu); const float nb_ = bias - mu;
                float ps = 0.f;
#pragma unroll
                for (int kbl = 0; kbl < KBN; ++kbl)
#pragma unroll
                    for (int i = 0; i < 4; ++i) { p[kbl][i] = fexp2(fmaf(x[kbl][i], C1, nb_)); ps += p[kbl][i]; }
                l[h] = l[h] * alpha + ps; m[h] = mn;
                if (MODE != 0) {
                    if (__ballot(alpha != 1.0f) != 0ull) {
#pragma unroll
                        for (int db = 0; db < 8; ++db) O[h][db] = O[h][db] * alpha;
                    }
                }
            }
            if (MODE != 0) {
#pragma unroll
                for (int cl = 0; cl < CN; ++cl) {
                    u32x4 w; w.x = cvt_pk_bf16(p[2 * cl][0], p[2 * cl][1]); w.y = cvt_pk_bf16(p[2 * cl][2], p[2 * cl][3]);
                    w.z = cvt_pk_bf16(p[2 * cl + 1][0], p[2 * cl + 1][1]); w.w = cvt_pk_bf16(p[2 * cl + 1][2], p[2 * cl + 1][3]);
                    pk[h][cl] = __builtin_bit_cast(bf16x8, w);
                }
            }
        }
        if (MODE == 1) {
#pragma unroll
            for (int kbl = 0; kbl < KBN; ++kbl) {
                const float a = __shfl(carh[kbl], (lane - 16) & 63);
                const float b = __shfl(prevc, (lane + 48) & 63);
                const float cp = (g == 0) ? b : a;
                { LAS float* ip = ax.impw + r * 128 + 16 * T + 4 * (hf * KBN + kbl) + g; const float nv = mainh[kbl] + cp; *ip = ax.first ? nv : (*ip + nv); }
                prevc = carh[kbl];
            }
        }
        if (MODE != 0) {
#pragma unroll
            for (int cl = 0; cl < CN; ++cl)
#pragma unroll
                for (int db = 0; db < 8; ++db) {
                    const int cc = hf * CN + cl;
                    const unsigned cho = 32u * ((unsigned)db ^ wv);
                    const s16x4 v0 = vtr(vbuf + vrow + 4096u * (2 * cc) + cho), v1 = vtr(vbuf + vrow + 4096u * (2 * cc + 1) + cho);
                    const bf16x8 vf = {v0[0], v0[1], v0[2], v0[3], v1[0], v1[1], v1[2], v1[3]};
#pragma unroll
                    for (int h = 0; h < NH; ++h) O[h][db] = __builtin_amdgcn_mfma_f32_16x16x32_bf16(vf, pk[h][cl], O[h][db], 0, 0, 0);
                    if (NH > 1 && (db & 3) == 3) __builtin_amdgcn_sched_barrier(0);
                }
        }
    }
    if (MODE == 1) ax.tc = prevc;
}

template <int NH, int MODE>
__device__ __forceinline__ void attn_run(const Ctx& c, const bf16* Kg, int ldk, const bf16* Vg, int ldv, int tile_lo, int tile_hi,
                                         const bf16x8 (&Q)[NH][4], f32x4 (&O)[NH][8], float (&m)[NH], float (&l)[NH], int t, AX& ax) {
    if (tile_lo >= tile_hi) return;
    const int q_lo = __builtin_amdgcn_readfirstlane(t) & ~127;
    constexpr int NBUF = (MODE == 0 || MODE == 1) ? 2 : 4, DIST = NBUF - 1;
    __syncthreads();
#pragma unroll
    for (int d = 0; d < DIST; ++d) if (tile_lo + d < tile_hi) stage_kv(c.lds + d * KV_BUF, Kg, ldk, Vg, ldv, 64 * (tile_lo + d), c.wid, c.lane);
    for (int T = tile_lo; T < tile_hi; ++T) {
        const int cur = (T - tile_lo) & (NBUF - 1);
        if (DIST > 1 && T + DIST - 1 < tile_hi) { if (DIST == 3) asm volatile("s_waitcnt vmcnt(8)" ::: "memory"); else asm volatile("s_waitcnt vmcnt(4)" ::: "memory"); }
        else asm volatile("s_waitcnt vmcnt(0)" ::: "memory");
        __syncthreads();
        if (T + DIST < tile_hi) stage_kv(c.lds + ((T - tile_lo + DIST) & (NBUF - 1)) * KV_BUF, Kg, ldk, Vg, ldv, 64 * (T + DIST), c.wid, c.lane);
        bool colsel = true; bool doit = true;
        if (MODE == 2) {
            const int w = T >> 5; const unsigned word = (w == 0) ? ax.sel[0] : (w == 1) ? ax.sel[1] : (w == 2) ? ax.sel[2] : ax.sel[3];
            colsel = ((word >> (T & 31)) & 1u) != 0u;
            doit = __ballot(colsel) != 0ull;
        }
        bool em = false;
        if (MODE == 0 || MODE == 1) em = (1024 * T + 1039 > q_lo);
        if (MODE == 2) em = (64 * T + 63 > q_lo);
        if (MODE == 3) em = (64 * T + 63 > q_lo) || (64 * T <= q_lo + 127 - 512);
        if (doit) {
            if (em) attn_tile<NH, MODE, true, 0>(c.lds + cur * KV_BUF, c.lds + cur * KV_BUF + 16384, Q, O, m, l, 64 * T, T, t, c.lane, colsel ? 0xffu : 0u, ax);
            else attn_tile<NH, MODE, false, 0>(c.lds + cur * KV_BUF, c.lds + cur * KV_BUF + 16384, Q, O, m, l, 64 * T, T, t, c.lane, colsel ? 0xffu : 0u, ax);
        }
    }
}

__device__ __forceinline__ void load_q(bf16x8 (&Qh)[4], const bf16* rowp, const float* rope_t, int lane) {
    const int g = lane >> 4;
#pragma unroll
    for (int s = 0; s < 4; ++s) Qh[s] = *(const bf16x8*)(rowp + 32 * s + 8 * g);
    if (rope_t) {
        const u32x4 own = __builtin_bit_cast(u32x4, Qh[0]); u32x4 par;
        par.x = __shfl_xor(own.x, 32); par.y = __shfl_xor(own.y, 32); par.z = __shfl_xor(own.z, 32); par.w = __shfl_xor(own.w, 32);
        const int f0 = 8 * (g & 1);
        const f32x4 c0 = *(const f32x4*)(rope_t + f0), c1 = *(const f32x4*)(rope_t + f0 + 4), s0 = *(const f32x4*)(rope_t + 16 + f0), s1 = *(const f32x4*)(rope_t + 16 + f0 + 4);
        const float sg = (g < 2) ? -1.f : 1.f;
        const float o0 = bflo(own.x) * c0.x + sg * bflo(par.x) * s0.x, o1 = bfhi(own.x) * c0.y + sg * bfhi(par.x) * s0.y;
        const float o2 = bflo(own.y) * c0.z + sg * bflo(par.y) * s0.z, o3 = bfhi(own.y) * c0.w + sg * bfhi(par.y) * s0.w;
        const float o4 = bflo(own.z) * c1.x + sg * bflo(par.z) * s1.x, o5 = bfhi(own.z) * c1.y + sg * bfhi(par.z) * s1.y;
        const float o6 = bflo(own.w) * c1.z + sg * bflo(par.w) * s1.z, o7 = bfhi(own.w) * c1.w + sg * bfhi(par.w) * s1.w;
        u32x4 w; w.x = cvt_pk_bf16(o0, o1); w.y = cvt_pk_bf16(o2, o3); w.z = cvt_pk_bf16(o4, o5); w.w = cvt_pk_bf16(o6, o7);
        Qh[0] = __builtin_bit_cast(bf16x8, w);
    }
}
__device__ __forceinline__ float red_g(float v) { return gsum4(v); }
__device__ __forceinline__ float sigmoidf_(float x) { return 1.0f / (1.0f + __expf(-x)); }

__device__ __forceinline__ void nsa_cmp_item(const Ctx& c, const Args& a, int nb, int grp) {
    unsigned char* ws = a.ws;
    const bf16* UNSA = (const bf16*)(ws + WS_UNSA);
    const float* ROPE = (const float*)(ws + WS_ROPE); float* TMP = (float*)(ws + WS_TMP);
    const int lane = c.lane, g = lane >> 4, r = lane & 15;
    const int t = 128 * nb + 16 * c.wid + r;
    const float NEG = -__builtin_inff();
    AX ax; ax.impw = (LAS float*)(c.lds + IMP_OFF) + c.wid * (16 * 128); ax.tc = 0.f; ax.linv[0] = ax.linv[1] = ax.linv[2] = 0.f; ax.first = true; ax.sel[0] = ax.sel[1] = ax.sel[2] = ax.sel[3] = 0u;
    const int nT = (8 * nb + 70) >> 6;
    const bf16* KCC = (const bf16*)(ws + WS_KCC) + (size_t)grp * 512 * 128; const bf16* VCC = (const bf16*)(ws + WS_VCC) + (size_t)grp * 512 * 128;
#pragma unroll 1
    for (int h = 0; h < 3; ++h) {
        const int head = 3 * grp + h;
        bf16x8 Q[1][4]; load_q(Q[0], UNSA + (size_t)t * NNSA + head * 128, ROPE + (size_t)t * 32, lane);
        f32x4 O[1][8]; float m[1], l[1];
        m[0] = NEG; l[0] = 0.f;
#pragma unroll
        for (int db = 0; db < 8; ++db) O[0][db] = (f32x4){0.f, 0.f, 0.f, 0.f};
        attn_run<1, 0>(c, KCC, 128, VCC, 128, 0, nT, Q, O, m, l, t, ax);
        { const float lt = red_g(l[0]); ax.linv[0] = lt > 0.f ? 1.0f / lt : 0.f; m[0] = (m[0] == NEG) ? 0.f : m[0]; }
        ax.tc = 0.f; ax.first = (h == 0);
        attn_run<1, 1>(c, KCC, 128, VCC, 128, 0, nT, Q, O, m, l, t, ax);
        const float gt = sigmoidf_(bf2f(UNSA[(size_t)t * NNSA + 2048 + 3 * head + 0]));
        float* tmpq = TMP + (size_t)t * QW + head * 128 + 4 * g;
#pragma unroll
        for (int db = 0; db < 8; ++db) *(f32x4*)(tmpq + 16 * db) = O[0][db] * gt;
    }
    {
        float v[32];
        int g_ = g; asm volatile("" : "+v"(g_));
        const LAS f32x4* src = (const LAS f32x4*)(ax.impw + r * 128 + 32 * g_);
#pragma unroll
        for (int k4 = 0; k4 < 8; ++k4) { const f32x4 w = src[k4]; v[4 * k4] = w.x; v[4 * k4 + 1] = w.y; v[4 * k4 + 2] = w.z; v[4 * k4 + 3] = w.w; }
        const int jt = t >> 6; const float PINF = __builtin_inff();
#pragma unroll
        for (int k = 0; k < 32; ++k) { const int j = 32 * g_ + k; v[k] = (j == 0 || j == jt || j == jt - 1) ? PINF : ((j > jt) ? NEG : v[k]); }
        unsigned selown = 0u;
#pragma unroll 1
        for (int round = 0; round < 16; ++round) {
            float bv = v[0]; int bk = 0;
#pragma unroll
            for (int k = 1; k < 32; ++k) { const bool gt = v[k] > bv; bv = gt ? v[k] : bv; bk = gt ? k : bk; }
            int bidx = 32 * g_ + bk;
#pragma unroll
            for (int o = 16; o <= 32; o <<= 1) { const float ov = __shfl_xor(bv, o); const int oi = __shfl_xor(bidx, o); const bool take = (ov > bv) || (ov == bv && oi < bidx); bv = take ? ov : bv; bidx = take ? oi : bidx; }
            const bool mine = (bidx >> 5) == g_; const int kk = bidx & 31;
            selown |= mine ? (1u << kk) : 0u;
#pragma unroll
            for (int k = 0; k < 32; ++k) v[k] = (mine && k == kk) ? NEG : v[k];
        }
        ((unsigned*)(ws + WS_SELB))[((size_t)t * 4 + grp) * 4 + g_] = selown;
    }
}

__device__ __forceinline__ void nsa_sw_item(const Ctx& c, const Args& a, int nb, int head) {
    unsigned char* ws = a.ws;
    const bf16* UNSA = (const bf16*)(ws + WS_UNSA); const bf16* UKV = (const bf16*)(ws + WS_UKV);
    const float* ROPE = (const float*)(ws + WS_ROPE); const float* TMP = (const float*)(ws + WS_TMP); bf16* CAT = (bf16*)(ws + WS_CAT);
    const int lane = c.lane, g = lane >> 4, r = lane & 15, grp = head / 3;
    const int t = 128 * nb + 16 * c.wid + r;
    const float NEG = -__builtin_inff();
    AX ax; ax.impw = nullptr; ax.tc = 0.f; ax.linv[0] = ax.linv[1] = ax.linv[2] = 0.f; ax.first = true;
    { const u32x4 sw = *(const u32x4*)((const unsigned*)(ws + WS_SELB) + ((size_t)t * 4 + grp) * 4); ax.sel[0] = sw.x; ax.sel[1] = sw.y; ax.sel[2] = sw.z; ax.sel[3] = sw.w; }
    bf16x8 Q[1][4]; load_q(Q[0], UNSA + (size_t)t * NNSA + head * 128, ROPE + (size_t)t * 32, lane);
    f32x4 O[1][8]; float m[1], l[1];
    m[0] = NEG; l[0] = 0.f;
#pragma unroll
    for (int db = 0; db < 8; ++db) O[0][db] = (f32x4){0.f, 0.f, 0.f, 0.f};
    attn_run<1, 2>(c, (const bf16*)(ws + WS_KSR) + (size_t)grp * S * 128, 128, UKV + 1536 + grp * 128, NKV, 0, 2 * nb + 2, Q, O, m, l, t, ax);
    f32x4 acc[8];
    { const float lt = red_g(l[0]); const float sc = (lt > 0.f ? 1.0f / lt : 0.f) * sigmoidf_(bf2f(UNSA[(size_t)t * NNSA + 2048 + 3 * head + 1]));
      const float* tmpq = TMP + (size_t)t * QW + head * 128 + 4 * g;
#pragma unroll
      for (int db = 0; db < 8; ++db) acc[db] = *(const f32x4*)(tmpq + 16 * db) + O[0][db] * sc; }
    m[0] = NEG; l[0] = 0.f;
#pragma unroll
    for (int db = 0; db < 8; ++db) O[0][db] = (f32x4){0.f, 0.f, 0.f, 0.f};
    attn_run<1, 3>(c, (const bf16*)(ws + WS_KWR) + (size_t)grp * S * 128, 128, UKV + 2560 + grp * 128, NKV, (2 * nb - 8) > 0 ? (2 * nb - 8) : 0, 2 * nb + 2, Q, O, m, l, t, ax);
    { const float lt = red_g(l[0]); const float sc = (lt > 0.f ? 1.0f / lt : 0.f) * sigmoidf_(bf2f(UNSA[(size_t)t * NNSA + 2048 + 3 * head + 2]));
      bf16* catq = CAT + (size_t)t * D + head * 128 + 4 * g;
#pragma unroll
      for (int db = 0; db < 8; ++db) { const f32x4 o = acc[db] + O[0][db] * sc; u32x2 w; w.x = cvt_pk_bf16(o.x, o.y); w.y = cvt_pk_bf16(o.z, o.w); *(u32x2*)(catq + 16 * db) = w; } }
}

struct AX2 { const LAS unsigned* selw; };
constexpr int SELW_OFF = 131072;
template <int MODE>
__device__ __forceinline__ void attn_run2(const Ctx& c, const bf16* Kg, int ldk, const bf16* Vg, int ldv, int tile_lo, int tile_hi,
                                          const bf16x8 (&Q)[2][4], f32x4 (&O)[2][8], float (&m)[2], float (&l)[2], int t0, const AX2& a2, AX& ax, int lane) {
    const int kh = c.wid >> 2, qs = c.wid & 3;
    const int q_lo = __builtin_amdgcn_readfirstlane(t0) & ~127;
    const int npairs = (tile_hi - tile_lo + 1) >> 1;
    __syncthreads();
    if (npairs > 0) { stage_kv(c.lds, Kg, ldk, Vg, ldv, 64 * tile_lo, c.wid, lane); if (tile_lo + 1 < tile_hi) stage_kv(c.lds + KV_BUF, Kg, ldk, Vg, ldv, 64 * (tile_lo + 1), c.wid, lane); }
    for (int pi = 0; pi < npairs; ++pi) {
        const int cur = pi & 1;
        asm volatile("s_waitcnt vmcnt(0)" ::: "memory");
        __syncthreads();
        if (pi + 1 < npairs) { const int Tn = tile_lo + 2 * (pi + 1);
            stage_kv(c.lds + (cur ^ 1) * 2 * KV_BUF, Kg, ldk, Vg, ldv, 64 * Tn, c.wid, lane);
            if (Tn + 1 < tile_hi) stage_kv(c.lds + (cur ^ 1) * 2 * KV_BUF + KV_BUF, Kg, ldk, Vg, ldv, 64 * (Tn + 1), c.wid, lane); }
        const int T = tile_lo + 2 * pi + kh;
        if (T < tile_hi) {
            unsigned csel = 3u; bool doit = true;
            if (MODE == 2) {
                const int w = T >> 5;
                const unsigned w0 = a2.selw[(lane & 15) * 4 + w], w1 = a2.selw[(16 + (lane & 15)) * 4 + w];
                csel = ((w0 >> (T & 31)) & 1u) | (((w1 >> (T & 31)) & 1u) << 1);
                doit = __ballot(csel != 0u) != 0ull;
            }
            bool em = false;
            if (MODE == 2) em = (64 * T + 63 > q_lo);
            if (MODE == 3) em = (64 * T + 63 > q_lo) || (64 * T <= q_lo + 127 - 512);
            LAS unsigned char* kb_ = c.lds + cur * 2 * KV_BUF + kh * KV_BUF;
            if (doit) {
                if (em) attn_tile<2, MODE, true, 16>(kb_, kb_ + 16384, Q, O, m, l, 64 * T, T, t0, lane, csel, ax);
                else attn_tile<2, MODE, false, 16>(kb_, kb_ + 16384, Q, O, m, l, 64 * T, T, t0, lane, csel, ax);
            }
        }
    }
    __syncthreads();
    LAS float* mb = (LAS float*)c.lds + qs * (68 * 64) + lane;
    if (kh == 1) {
#pragma unroll
        for (int b = 0; b < 2; ++b) { mb[(b * 34 + 0) * 64] = m[b]; mb[(b * 34 + 1) * 64] = l[b];
#pragma unroll
            for (int db = 0; db < 8; ++db) { mb[(b * 34 + 2 + 4 * db) * 64] = O[b][db].x; mb[(b * 34 + 3 + 4 * db) * 64] = O[b][db].y; mb[(b * 34 + 4 + 4 * db) * 64] = O[b][db].z; mb[(b * 34 + 5 + 4 * db) * 64] = O[b][db].w; } }
    }
    __syncthreads();
    if (kh == 0) {
        const float NEG = -__builtin_inff();
#pragma unroll
        for (int b = 0; b < 2; ++b) { const float mo = mb[(b * 34 + 0) * 64], lo_ = mb[(b * 34 + 1) * 64];
            const float mn = fmaxf(m[b], mo); const float mu = (mn == NEG) ? 0.f : mn; const float sa = fexp2(m[b] - mu), sb = fexp2(mo - mu);
            l[b] = l[b] * sa + lo_ * sb; m[b] = mn;
#pragma unroll
            for (int db = 0; db < 8; ++db) { f32x4 o; o.x = mb[(b * 34 + 2 + 4 * db) * 64]; o.y = mb[(b * 34 + 3 + 4 * db) * 64]; o.z = mb[(b * 34 + 4 + 4 * db) * 64]; o.w = mb[(b * 34 + 5 + 4 * db) * 64];
                O[b][db] = O[b][db] * sa + o * sb; } }
    }
}

__device__ __forceinline__ void nsa_sw_item2(const Ctx& c, const Args& a, int nb, int head) {
    unsigned char* ws = a.ws;
    const bf16* UNSA = (const bf16*)(ws + WS_UNSA); const bf16* UKV = (const bf16*)(ws + WS_UKV);
    const float* ROPE = (const float*)(ws + WS_ROPE); float* TMP = (float*)(ws + WS_TMP); bf16* CAT = (bf16*)(ws + WS_CAT);
    int lane = c.lane; asm volatile("" : "+v"(lane));
    const int g = lane >> 4, r = lane & 15, grp = head / 3, kh = c.wid >> 2, qs = c.wid & 3;
    const int t0 = 128 * nb + 32 * qs + r;
    const float NEG = -__builtin_inff();
    AX ax; ax.impw = nullptr; ax.tc = 0.f; ax.linv[0] = ax.linv[1] = ax.linv[2] = 0.f; ax.first = true; ax.sel[0] = ax.sel[1] = ax.sel[2] = ax.sel[3] = 0u;
    AX2 a2; a2.selw = (const LAS unsigned*)(c.lds + SELW_OFF) + (32 * qs) * 4;
    bf16x8 Q[2][4];
#pragma unroll
    for (int b = 0; b < 2; ++b) { const int tb = t0 + 16 * b;
        ((LAS unsigned*)(c.lds + SELW_OFF))[(32 * qs + 16 * b + r) * 4 + g] = ((const unsigned*)(ws + WS_SELB))[((size_t)tb * 4 + grp) * 4 + g];
        load_q(Q[b], UNSA + (size_t)tb * NNSA + head * 128, ROPE + (size_t)tb * 32, lane); }
    f32x4 O[2][8]; float m[2], l[2];
#pragma unroll
    for (int b = 0; b < 2; ++b) { m[b] = NEG; l[b] = 0.f;
#pragma unroll
        for (int db = 0; db < 8; ++db) O[b][db] = (f32x4){0.f, 0.f, 0.f, 0.f}; }
    attn_run2<2>(c, (const bf16*)(ws + WS_KSR) + (size_t)grp * S * 128, 128, UKV + 1536 + grp * 128, NKV, 0, 2 * nb + 2, Q, O, m, l, t0, a2, ax, lane);
    if (kh == 0) {
#pragma unroll
        for (int b = 0; b < 2; ++b) { const int tb = t0 + 16 * b; const float lt = red_g(l[b]); const float sc = (lt > 0.f ? 1.0f / lt : 0.f) * sigmoidf_(bf2f(UNSA[(size_t)tb * NNSA + 2048 + 3 * head + 1]));
            float* tmpq = TMP + (size_t)tb * QW + head * 128 + 4 * g;
#pragma unroll
            for (int db = 0; db < 8; ++db) { f32x4* p = (f32x4*)(tmpq + 16 * db); *p = *p + O[b][db] * sc; } }
    }
#pragma unroll
    for (int b = 0; b < 2; ++b) { m[b] = NEG; l[b] = 0.f;
#pragma unroll
        for (int db = 0; db < 8; ++db) O[b][db] = (f32x4){0.f, 0.f, 0.f, 0.f}; }
    attn_run2<3>(c, (const bf16*)(ws + WS_KWR) + (size_t)grp * S * 128, 128, UKV + 2560 + grp * 128, NKV, (2 * nb - 8) > 0 ? (2 * nb - 8) : 0, 2 * nb + 2, Q, O, m, l, t0, a2, ax, lane);
    if (kh == 0) {
#pragma unroll
        for (int b = 0; b < 2; ++b) { const int tb = t0 + 16 * b; const float lt = red_g(l[b]); const float sc = (lt > 0.f ? 1.0f / lt : 0.f) * sigmoidf_(bf2f(UNSA[(size_t)tb * NNSA + 2048 + 3 * head + 2]));
            const float* tmpq = TMP + (size_t)tb * QW + head * 128 + 4 * g; bf16* catq = CAT + (size_t)tb * D + head * 128 + 4 * g;
#pragma unroll
            for (int db = 0; db < 8; ++db) { const f32x4 o = *(const f32x4*)(tmpq + 16 * db) + O[b][db] * sc; u32x2 w; w.x = cvt_pk_bf16(o.x, o.y); w.y = cvt_pk_bf16(o.z, o.w); *(u32x2*)(catq + 16 * db) = w; } }
    }
}

__device__ __forceinline__ void mem_item(const Ctx& c, const Args& a, const bf16* qsrc, int ldq, int qcol, const bf16* memkv, int qb, int head) {
    const int lane = c.lane, g = lane >> 4, r = lane & 15;
    const int t = 128 * qb + 16 * c.wid + r;
    bf16x8 Q[1][4]; load_q(Q[0], qsrc + (size_t)t * ldq + qcol + head * 128, nullptr, lane);
    f32x4 O[1][8]; float m[1], l[1]; AX ax; ax.impw = nullptr; ax.first = true; ax.sel[0] = ax.sel[1] = ax.sel[2] = ax.sel[3] = 0u; ax.tc = 0.f; ax.linv[0] = ax.linv[1] = ax.linv[2] = 0.f;
    m[0] = -__builtin_inff(); l[0] = 0.f;
#pragma unroll
    for (int db = 0; db < 8; ++db) O[0][db] = (f32x4){0.f, 0.f, 0.f, 0.f};
    attn_run<1, 4>(c, memkv + head * 128, MEMKVW, memkv + 512 + head * 128, MEMKVW, 0, NMEM / 64, Q, O, m, l, t, ax);
    const float lt = red_g(l[0]); const float sc = lt > 0.f ? 1.0f / lt : 0.f;
    bf16* catq = (bf16*)(a.ws + WS_CAT) + (size_t)t * D + QW + head * 128 + 4 * g;
#pragma unroll
    for (int db = 0; db < 8; ++db) { const f32x4 o = O[0][db] * sc; u32x2 w; w.x = cvt_pk_bf16(o.x, o.y); w.y = cvt_pk_bf16(o.z, o.w); *(u32x2*)(catq + 16 * db) = w; }
}

__device__ __forceinline__ void unpack8(const u32x4 w, float (&f)[8]) { f[0] = bflo(w.x); f[1] = bfhi(w.x); f[2] = bflo(w.y); f[3] = bfhi(w.y); f[4] = bflo(w.z); f[5] = bfhi(w.z); f[6] = bflo(w.w); f[7] = bfhi(w.w); }
__device__ __forceinline__ u32x4 pack8(const float (&f)[8]) { u32x4 w; w.x = cvt_pk_bf16(f[0], f[1]); w.y = cvt_pk_bf16(f[2], f[3]); w.z = cvt_pk_bf16(f[4], f[5]); w.w = cvt_pk_bf16(f[6], f[7]); return w; }

__device__ __forceinline__ void conv_phase(const Ctx& c, const Args& a) {
    const bf16* U = (const bf16*)(a.ws + WS_UCONV); bf16* CAT = (bf16*)(a.ws + WS_CAT); const float* cw = (const float*)a.in[12];
    for (int idx = c.bid * NTHREADS + c.tid; idx < S * (CONVC / 8); idx += c.G * NTHREADS) {
        const int t = idx / (CONVC / 8), ch = (idx - t * (CONVC / 8)) * 8;
        float acc[8] = {0.f, 0.f, 0.f, 0.f, 0.f, 0.f, 0.f, 0.f};
#pragma unroll
        for (int k = 0; k < 3; ++k) { const int tt = t - 2 + k;
            if (tt >= 0) { float gc[8], hv[8]; unpack8(*(const u32x4*)(U + (size_t)tt * NCONV + CONVC + ch), gc); unpack8(*(const u32x4*)(U + (size_t)tt * NCONV + 2 * CONVC + ch), hv);
                const f32x4 w0 = *(const f32x4*)(cw + k * CONVC + ch), w1 = *(const f32x4*)(cw + k * CONVC + ch + 4);
                acc[0] += w0.x * (gc[0] * hv[0]); acc[1] += w0.y * (gc[1] * hv[1]); acc[2] += w0.z * (gc[2] * hv[2]); acc[3] += w0.w * (gc[3] * hv[3]);
                acc[4] += w1.x * (gc[4] * hv[4]); acc[5] += w1.y * (gc[5] * hv[5]); acc[6] += w1.z * (gc[6] * hv[6]); acc[7] += w1.w * (gc[7] * hv[7]); } }
        float gb[8]; unpack8(*(const u32x4*)(U + (size_t)t * NCONV + ch), gb);
#pragma unroll
        for (int j = 0; j < 8; ++j) acc[j] *= gb[j];
        *(u32x4*)(CAT + (size_t)t * D + ch) = pack8(acc);
    }
}

__device__ __forceinline__ void kvpost_phase(const Ctx& c, const Args& a) {
    const bf16* UKV = (const bf16*)(a.ws + WS_UKV); const float* ROPE = (const float*)(a.ws + WS_ROPE);
    for (int idx = c.bid * NTHREADS + c.tid; idx < S * 256; idx += c.G * NTHREADS) {
        const int t = idx >> 8, rem = idx & 255, which = rem >> 6, grp = (rem >> 4) & 3, ch = rem & 15;
        const int colbase = (which == 0) ? 0 : (which == 1) ? 512 : (which == 2) ? 1024 : 2048;
        const size_t dsto = (which == 0) ? WS_KCR : (which == 1) ? WS_VCR : (which == 2) ? WS_KSR : WS_KWR;
        const bf16* src = UKV + (size_t)t * NKV + colbase + grp * 128;
        bf16* dst = (bf16*)(a.ws + dsto) + ((size_t)grp * S + t) * 128;
        u32x4 own = *(const u32x4*)(src + 8 * ch);
        if (which != 1 && ch < 4) {
            const u32x4 par = *(const u32x4*)(src + 8 * (ch ^ 2));
            float xo[8], xp[8], o[8]; unpack8(own, xo); unpack8(par, xp);
            const float* rt = ROPE + (size_t)t * 32 + 8 * (ch & 1); const float sg = (ch < 2) ? -1.f : 1.f;
#pragma unroll
            for (int j = 0; j < 8; ++j) o[j] = xo[j] * rt[j] + sg * xp[j] * rt[16 + j];
            own = pack8(o);
        }
        *(u32x4*)(dst + 8 * ch) = own;
    }
}

__device__ __forceinline__ float gelu_tanh(float x) { const float y = 0.7978845608028654f * (x + 0.044715f * x * x * x); const float e = __expf(2.0f * y); const float th = 1.0f - 2.0f / (e + 1.0f); return 0.5f * x * (1.0f + th); }
__device__ __forceinline__ void compress_item(const Ctx& c, const bf16* src, const float* pos, const bf16* w1t, const bf16* w2t, bf16* dst, int rg) {
    const int lane = c.lane, g = lane >> 4, r = lane & 15, wid = c.wid;
    const int mrow = 16 * rg + r;
    const bf16* arow = src + (size_t)mrow * 2048;
    f32x4 acc[8];
#pragma unroll
    for (int nb = 0; nb < 8; ++nb) acc[nb] = (f32x4){0.f, 0.f, 0.f, 0.f};
#pragma unroll 2
    for (int ks = 0; ks < 16; ++ks) {
        const int k = 512 * wid + 32 * ks + 8 * g;
        float xa[8]; unpack8(*(const u32x4*)(arow + k), xa);
        const f32x4 p0 = *(const f32x4*)(pos + k), p1 = *(const f32x4*)(pos + k + 4);
        xa[0] += p0.x; xa[1] += p0.y; xa[2] += p0.z; xa[3] += p0.w; xa[4] += p1.x; xa[5] += p1.y; xa[6] += p1.z; xa[7] += p1.w;
        const bf16x8 xb = __builtin_bit_cast(bf16x8, pack8(xa));
#pragma unroll
        for (int nb = 0; nb < 8; ++nb) { const bf16x8 wf = *(const bf16x8*)(w1t + (size_t)(16 * nb + r) * 4096 + k); acc[nb] = __builtin_amdgcn_mfma_f32_16x16x32_bf16(wf, xb, acc[nb], 0, 0, 0); }
    }
    LAS f32x4* red = (LAS f32x4*)c.lds;
    __syncthreads();
#pragma unroll
    for (int nb = 0; nb < 8; ++nb) red[(wid * 8 + nb) * 64 + lane] = acc[nb];
    __syncthreads();
    if (wid == 0) {
        float hid[8][4];
#pragma unroll
        for (int nb = 0; nb < 8; ++nb) { f32x4 s = red[nb * 64 + lane];
#pragma unroll
            for (int w = 1; w < 8; ++w) s = s + red[(w * 8 + nb) * 64 + lane];
            hid[nb][0] = gelu_tanh(s.x); hid[nb][1] = gelu_tanh(s.y); hid[nb][2] = gelu_tanh(s.z); hid[nb][3] = gelu_tanh(s.w); }
        f32x4 o2[8];
#pragma unroll
        for (int ob = 0; ob < 8; ++ob) o2[ob] = (f32x4){0.f, 0.f, 0.f, 0.f};
#pragma unroll
        for (int cc = 0; cc < 4; ++cc) {
            u32x4 bw; bw.x = cvt_pk_bf16(hid[2 * cc][0], hid[2 * cc][1]); bw.y = cvt_pk_bf16(hid[2 * cc][2], hid[2 * cc][3]); bw.z = cvt_pk_bf16(hid[2 * cc + 1][0], hid[2 * cc + 1][1]); bw.w = cvt_pk_bf16(hid[2 * cc + 1][2], hid[2 * cc + 1][3]);
            const bf16x8 bfrag = __builtin_bit_cast(bf16x8, bw);
#pragma unroll
            for (int ob = 0; ob < 8; ++ob) { const bf16* wr_ = w2t + (size_t)(16 * ob + r) * 128 + 32 * cc + 4 * g;
                const u32x2 a0 = *(const u32x2*)wr_, a1 = *(const u32x2*)(wr_ + 16);
                u32x4 aw; aw.x = a0.x; aw.y = a0.y; aw.z = a1.x; aw.w = a1.y;
                o2[ob] = __builtin_amdgcn_mfma_f32_16x16x32_bf16(__builtin_bit_cast(bf16x8, aw), bfrag, o2[ob], 0, 0, 0); }
        }
#pragma unroll
        for (int ob = 0; ob < 8; ++ob) { u32x2 w; w.x = cvt_pk_bf16(o2[ob].x, o2[ob].y); w.y = cvt_pk_bf16(o2[ob].z, o2[ob].w); *(u32x2*)(dst + (size_t)mrow * 128 + 16 * ob + 4 * g) = w; }
    }
}

#define XB_TMO      128
#define XB_XCNT(j)  (256  + 64 * (j))
#define XB_XSUB(j)  (1280 + 64 * (j))
#define XB_XGEN(j)  (2304 + 64 * (j))
#define XB_TOP      3328
#define XB_TOPGEN   3392
#define XCD_BAR_WORDS 3456
#define XB_SPIN_CAP (1u << 18)

__device__ __forceinline__ unsigned xb_ld(unsigned* p)              { return __hip_atomic_load(p, __ATOMIC_RELAXED, __HIP_MEMORY_SCOPE_AGENT); }
__device__ __forceinline__ unsigned xb_add(unsigned* p, unsigned v) { return __hip_atomic_fetch_add(p, v, __ATOMIC_RELAXED, __HIP_MEMORY_SCOPE_AGENT); }
__device__ __forceinline__ unsigned xb_xcc_id() { return (unsigned)__builtin_amdgcn_s_getreg((3 << 11) | 20) & 0xFu; }
#define XB_SPIN(cond, bar) do { unsigned _sp = 0; while (cond) { __builtin_amdgcn_s_sleep(1); \
    if ((++_sp & 255u) == 0u) { if (xb_ld(&(bar)[XB_TMO])) break; if (_sp > XB_SPIN_CAP) { atomicAdd(&(bar)[XB_TMO], 1u); break; } } } } while (0)

struct XcdBarrier {
    unsigned* bar; unsigned x;
    volatile LAS unsigned* st;
};

__device__ __forceinline__ XcdBarrier xcd_barrier_post(unsigned* bar, volatile LAS unsigned* st) {
    XcdBarrier b; b.bar = bar; b.x = xb_xcc_id(); b.st = st;
    if (threadIdx.x == 0) (void)xb_add(&bar[XB_XCNT(b.x)], 1u);
    return b;
}
__device__ __forceinline__ void xcd_barrier_complete(unsigned* bar, unsigned x, unsigned& nloc, unsigned& nx) {
    const unsigned G = gridDim.x * gridDim.y * gridDim.z;
    unsigned sum, cnt, mine, sp = 0u;
    for (;;) {
        sum = 0u; cnt = 0u; mine = 0u;
#pragma unroll
        for (unsigned j = 0; j < 16; ++j) { const unsigned c = xb_ld(&bar[XB_XCNT(j)]); sum += c; cnt += (c > 0u) ? 1u : 0u; mine = (j == x) ? c : mine; }
        if (sum == G) break;
        __builtin_amdgcn_s_sleep(1);
        if ((++sp & 255u) == 0u) { if (xb_ld(&bar[XB_TMO])) break; if (sp > XB_SPIN_CAP) { atomicAdd(&bar[XB_TMO], 1u); break; } }
    }
    nloc = mine > 0u ? mine : 1u; nx = cnt > 0u ? cnt : 1u;
}

__device__ __forceinline__ void xcd_barrier(const XcdBarrier& b) {
    asm volatile("s_waitcnt vmcnt(0)" ::: "memory");
    __syncthreads();
    if (threadIdx.x == 0) {
        unsigned* bar = b.bar;
        __builtin_amdgcn_s_waitcnt(0);
        unsigned nloc = b.st[0], nx = b.st[1];
        if (nloc == 0u) { xcd_barrier_complete(bar, b.x, nloc, nx); b.st[0] = nloc; b.st[1] = nx; }
        const unsigned old = xb_add(&bar[XB_XSUB(b.x)], 1u);
        const unsigned gen = old / nloc;
        if (old + 1u == (gen + 1u) * nloc) {
            __builtin_amdgcn_fence(__ATOMIC_RELEASE, "agent");
            asm volatile("s_waitcnt vmcnt(0)" ::: "memory");
            const unsigned og = xb_add(&bar[XB_TOP], 1u);
            const unsigned tg = og / nx;
            if (og + 1u == (tg + 1u) * nx) xb_add(&bar[XB_TOPGEN], 1u);
            else XB_SPIN(xb_ld(&bar[XB_TOPGEN]) == tg, bar);
            __builtin_amdgcn_fence(__ATOMIC_ACQUIRE, "agent");
            xb_add(&bar[XB_XGEN(b.x)], 1u);
            asm volatile("s_waitcnt vmcnt(0)" ::: "memory");
        } else {
            XB_SPIN(xb_ld(&bar[XB_XGEN(b.x)]) == gen, bar);
            __builtin_amdgcn_fence(__ATOMIC_ACQUIRE, "agent");
            asm volatile("s_waitcnt vmcnt(0)" ::: "memory");
        }
    }
    __syncthreads();
}

constexpr int MISC_OFF = 131072 + 2048;
__device__ const unsigned short SW_OFF[257] = {0,2,4,6,8,10,12,14,16,18,20,22,24,26,28,30,32,34,36,38,40,42,44,46,48,50,52,54,56,58,60,62,64,66,68,70,72,74,76,78,80,82,84,86,88,90,92,94,96,98,100,102,104,106,108,110,112,114,116,118,120,122,124,126,128,130,132,134,136,138,140,142,144,146,148,150,152,154,156,158,160,162,164,166,168,170,172,174,176,178,180,182,184,186,188,190,192,194,196,198,200,202,204,206,208,210,212,214,216,218,220,222,224,226,228,230,232,234,236,238,240,242,244,246,248,250,252,254,256,258,260,262,264,266,268,270,272,274,276,278,280,282,284,286,288,290,292,294,296,298,300,302,304,306,308,310,312,316,320,324,328,333,338,343,348,353,358,363,368,372,376,380,384,389,394,399,404,409,414,419,424,428,432,436,440,445,450,455,460,465,470,475,480,484,488,492,496,501,506,511,516,521,526,531,536,540,544,548,552,557,562,567,572,577,582,587,592,596,600,604,608,613,618,623,628,633,638,643,648,652,656,660,664,669,674,679,684,689,694,699,704,708,712,716,720,724,728,732,736,740,744,748,752,756,760,764,768};
__device__ const unsigned short SW_TAB[768] = {0,300,1,301,2,302,3,303,4,304,5,305,6,306,7,307,8,308,9,309,10,310,11,311,12,288,13,289,14,290,15,291,16,292,17,293,18,294,19,295,20,296,21,297,22,298,23,299,24,276,25,277,26,278,27,279,28,280,29,281,30,282,31,283,32,284,33,285,34,286,35,287,36,264,37,265,38,266,39,267,40,268,41,269,42,270,43,271,44,272,45,273,46,274,47,275,48,252,49,253,50,254,51,255,52,256,53,257,54,258,55,259,56,260,57,261,58,262,59,263,60,240,61,241,62,242,63,243,64,244,65,245,66,246,67,247,68,248,69,249,70,250,71,251,72,228,73,229,74,230,75,231,76,232,77,233,78,234,79,235,80,236,81,237,82,238,83,239,84,216,85,217,86,218,87,219,88,220,89,221,90,222,91,223,92,224,93,225,94,226,95,227,96,204,97,205,98,206,99,207,100,208,101,209,102,210,103,211,104,212,105,213,106,214,107,215,108,192,109,193,110,194,111,195,112,196,113,197,114,198,115,199,116,200,117,201,118,202,119,203,120,180,121,181,122,182,123,183,124,184,125,185,126,186,127,187,128,188,129,189,130,190,131,191,132,168,133,169,134,170,135,171,136,172,137,173,138,174,139,175,140,176,141,177,142,178,143,179,144,156,145,157,146,158,147,159,148,160,149,161,150,162,151,163,152,164,153,165,154,166,155,167,312,500,524,640,313,501,525,641,314,502,526,642,315,503,527,643,316,512,600,708,712,317,513,601,709,713,318,514,602,710,714,319,515,603,711,715,320,516,604,696,716,321,517,605,697,717,322,518,606,698,718,323,519,607,699,719,324,488,528,644,325,489,529,645,326,490,530,646,327,491,531,647,328,492,576,700,720,329,493,577,701,721,330,494,578,702,722,331,495,579,703,723,332,496,580,704,724,333,497,581,705,725,334,498,582,706,726,335,499,583,707,727,336,476,532,624,337,477,533,625,338,478,534,626,339,479,535,627,340,480,584,684,728,341,481,585,685,729,342,482,586,686,730,343,483,587,687,731,344,484,588,688,732,345,485,589,689,733,346,486,590,690,734,347,487,591,691,735,348,464,536,628,349,465,537,629,350,466,538,630,351,467,539,631,352,468,592,692,736,353,469,593,693,737,354,470,594,694,738,355,471,595,695,739,356,472,596,672,740,357,473,597,673,741,358,474,598,674,742,359,475,599,675,743,360,452,540,632,361,453,541,633,362,454,542,634,363,455,543,635,364,456,544,676,744,365,457,545,677,745,366,458,546,678,746,367,459,547,679,747,368,460,548,680,748,369,461,549,681,749,370,462,550,682,750,371,463,551,683,751,372,440,568,612,373,441,569,613,374,442,570,614,375,443,571,615,376,444,552,660,752,377,445,553,661,753,378,446,554,662,754,379,447,555,663,755,380,448,556,664,756,381,449,557,665,757,382,450,558,666,758,383,451,559,667,759,384,428,572,616,385,429,573,617,386,430,574,618,387,431,575,619,388,432,560,668,760,389,433,561,669,761,390,434,562,670,762,391,435,563,671,763,392,436,564,648,764,393,437,565,649,765,394,438,566,650,766,395,439,567,651,767,396,416,608,620,397,417,609,621,398,418,610,622,399,419,611,623,400,420,504,652,401,421,505,653,402,422,506,654,403,423,507,655,404,424,508,656,405,425,509,657,406,426,510,658,407,427,511,659,408,412,520,636,409,413,521,637,410,414,522,638,411,415,523,639};
#ifndef REPEAT_MASK
#define REPEAT_MASK 0u
#endif
__device__ __forceinline__ bool refresh(Ctx& c, int rep) { if (rep) __syncthreads(); int tid = threadIdx.x; asm volatile("" : "+v"(tid)); c.tid = tid; c.lane = tid & 63; return true; }
__global__ void __launch_bounds__(NTHREADS) fwd_megakernel(Args a) {
    extern __shared__ __attribute__((aligned(16))) unsigned char lds_raw[];
    __builtin_assume(__builtin_amdgcn_workitem_id_y() == 0); __builtin_assume(__builtin_amdgcn_workitem_id_z() == 0);
    cg::grid_group grid = cg::this_grid();
    Ctx c; c.lds = (LAS unsigned char*)lds_raw; c.tid = threadIdx.x; c.lane = c.tid & 63; c.wid = __builtin_amdgcn_readfirstlane(c.tid >> 6); c.G = gridDim.x; c.bid = blockIdx.x;
    unsigned char* ws = a.ws;
    const float* x = (const float*)a.in[0];
    float* SS = (float*)(ws + WS_SS); const float* kv_norm = (const float*)a.in[14];
    float* H = (float*)(ws + WS_H); bf16* XN = (bf16*)(ws + WS_XN); bf16* XKV = (bf16*)(ws + WS_XKV); bf16* ACT = (bf16*)(ws + WS_ACT);
    bf16* UCONV = (bf16*)(ws + WS_UCONV); bf16* UNSA = (bf16*)(ws + WS_UNSA); bf16* UKV = (bf16*)(ws + WS_UKV); bf16* CAT = (bf16*)(ws + WS_CAT);
    const float* ffn_norm = (const float*)a.in[3]; const float* mix_norm = (const float*)a.in[7];
    const int lo = a.ph_lo, hi = a.ph_hi;
    volatile LAS unsigned* MISC = (volatile LAS unsigned*)(c.lds + MISC_OFF);
    if (c.tid < 2) MISC[c.tid] = 0u;
    __syncthreads();
    XcdBarrier bar; bar.bar = (unsigned*)(ws + WS_CTL); bar.x = 0; bar.st = MISC;
    if (hi - lo > 1) bar = xcd_barrier_post((unsigned*)(ws + WS_CTL), MISC);
    const int rc = c.G - 1 - c.bid;
#define PH(k) if (lo <= (k) && (k) < hi) for (int rep_ = 0; rep_ <= (int)((REPEAT_MASK >> (k)) & 1u); ++rep_) if (refresh(c, rep_))
#define SYNC(k) if (lo <= (k) && (k) + 1 < hi) { xcd_barrier(bar); }
#define WGU(f) ((const bf16*)(ws + WS_WGU + (size_t)(f) * SZ_WGU))
#define WD(f) ((const bf16*)(ws + WS_WD + (size_t)(f) * SZ_WD))
    if (hi < 0) grid.sync();
    PH(0) { prologue(c, a); } SYNC(0)
    PH(1) { run_gemm(c, XN, WGU(0), S, NGU, D, EpiSwiGLU{ACT, FF}, c.bid);
            run_gemm(c, (const bf16*)(ws + WS_MEMN), (const bf16*)(ws + WS_WMEM), NMEM, MEMKVW, D, EpiPlain{(bf16*)(ws + WS_MEMKV), MEMKVW}, rc);
            run_gemm(c, (const bf16*)(ws + WS_MEMN + (size_t)NMEM * D * 2), (const bf16*)(ws + WS_WMEM + (size_t)MEMKVW * D * 2), NMEM, MEMKVW, D, EpiPlain{(bf16*)(ws + WS_MEMKV + (size_t)NMEM * MEMKVW * 2), MEMKVW}, (rc + c.G - 4) % c.G);
            if (c.G == 256 && c.bid >= 128 && c.bid < 248) convert_segs(c, a, CV_P1, c.bid - 128, 120); } SYNC(1)
    PH(2) { run_gemm(c, ACT, WD(0), S, D, FF, EpiRes{x, H, D, 0.5f, SS, XN}, c.bid); } SYNC(2)
    PH(4) { run_gemm(c, XN, (const bf16*)(ws + WS_WCONV), S, NCONV, D, EpiPlain{UCONV, NCONV, SS}, c.bid);
            if (c.G == 256 && c.bid >= 128) convert_segs(c, a, CV_P4, c.bid - 128, 128); } SYNC(4)
    PH(5) { conv_phase(c, a);
            for (int it = c.bid; it < 256; it += c.G) mem_item(c, a, UCONV, NCONV, 3 * CONVC, (const bf16*)(ws + WS_MEMKV), it >> 2, it & 3); } SYNC(5)
    PH(6) { run_gemm(c, CAT, (const bf16*)(ws + WS_WOUT), S, D, D, EpiRes{H, H, D, 1.0f, SS + S, XN}, c.bid); } SYNC(6)
    PH(8) { run_gemm(c, XN, WGU(1), S, NGU, D, EpiSwiGLU{ACT, FF, SS + S}, c.bid);
            if (c.G == 256 && c.bid >= 128) convert_segs(c, a, CV_P8, c.bid - 128, 128); } SYNC(8)
    PH(9) { run_gemm(c, ACT, WD(1), S, D, FF, EpiRes{H, H, D, 0.5f, SS + 2 * S, XN}, c.bid); } SYNC(9)
    PH(11) { run_gemm(c, XN, WGU(2), S, NGU, D, EpiSwiGLU{ACT, FF, SS + 2 * S}, c.bid);
             run_gemm(c, XN, (const bf16*)(ws + WS_WKV), S, NKV, D, EpiPlain{UKV, NKV, SS + 2 * S}, rc); } SYNC(11)
    PH(12) { run_gemm(c, ACT, WD(2), S, D, FF, EpiRes{H, H, D, 0.5f, SS + 3 * S, XN}, c.bid); kvpost_phase(c, a); } SYNC(12)
    PH(14) { run_gemm(c, XN, (const bf16*)(ws + WS_WNSA), S, NNSA, D, EpiPlain{UNSA, NNSA, SS + 3 * S}, c.bid);
             const int nfree = (c.G > 64) ? c.G - 32 : c.G, b0 = (c.G > 64) ? c.bid - 32 : c.bid;
             for (int it = b0; it >= 0 && it < 256; it += nfree) { const int w = it >> 7;
                 compress_item(c, (const bf16*)(ws + (w ? WS_VCR : WS_KCR)), (const float*)a.in[w ? 19 : 16], (const bf16*)(ws + WS_W1C + (size_t)w * 128 * 4096 * 2),
                               (const bf16*)(ws + WS_W2C + (size_t)w * 128 * 128 * 2), (bf16*)(ws + (w ? WS_VCC : WS_KCC)), it & 127); }
             if (c.G == 256 && c.bid >= 32) { __syncthreads(); convert_segs(c, a, CV_P14, c.bid - 32, 224); } } SYNC(14)
    PH(15) { for (int it = c.bid; it < 256; it += c.G) nsa_cmp_item(c, a, 63 - (it >> 2), it & 3); } SYNC(15)
    PH(16) { const int vb = (c.bid & 7) * 32 + (c.bid >> 3);
             const int k0 = (c.G == 256) ? (int)SW_OFF[vb] : c.bid, k1 = (c.G == 256) ? (int)SW_OFF[vb + 1] : 768, kst = (c.G == 256) ? 1 : c.G;
             for (int k = k0; k < k1; k += kst) { const int i = (c.G == 256) ? (int)SW_TAB[k] : k;
                 nsa_sw_item2(c, a, 63 - i / 12, i % 12); }
             for (int it = c.bid; it < 256; it += c.G) mem_item(c, a, UNSA, NNSA, QW, (const bf16*)(ws + WS_MEMKV + (size_t)NMEM * MEMKVW * 2), it >> 2, it & 3); } SYNC(16)
    PH(17) { run_gemm(c, CAT, (const bf16*)(ws + WS_WOUT + (size_t)D * D * 2), S, D, D, EpiRes{H, H, D, 1.0f, SS + 4 * S, XN}, c.bid); } SYNC(17)
    PH(19) { run_gemm(c, XN, WGU(3), S, NGU, D, EpiSwiGLU{ACT, FF, SS + 4 * S}, c.bid);
             if (c.G == 256 && c.bid >= 128) convert_segs(c, a, CV_P19, c.bid - 128, 128); } SYNC(19)
    PH(20) { run_gemm(c, ACT, WD(3), S, D, FF, EpiRes{H, H, D, 0.5f}, c.bid); } SYNC(20)
    PH(21) { norm_rows(c, H, S, (const float*)a.in[22], nullptr, nullptr, nullptr, a.out); }
#undef PH
#undef SYNC
}

extern "C" void kernel_launch(void* const* d_in, const int* in_sizes, int n_in, void* d_out, int out_size, void* d_ws, size_t ws_size, hipStream_t stream) {
    static int grid = 0;
    if (grid == 0) {
        if (n_in != 23 || out_size != S * D || ws_size < WS_END) { fprintf(stderr, "kernel_launch: unexpected problem (n_in %d, out %d, ws %zu < %zu)\n", n_in, out_size, ws_size, (size_t)WS_END); grid = -1; return; }
        int dev = 0, cus = 0, per_cu = 0;
        hipGetDevice(&dev); hipDeviceGetAttribute(&cus, hipDeviceAttributeMultiprocessorCount, dev);
        if (hipFuncSetAttribute((const void*)fwd_megakernel, hipFuncAttributeMaxDynamicSharedMemorySize, LDS_BYTES) != hipSuccess) { fprintf(stderr, "kernel_launch: hipFuncSetAttribute failed\n"); grid = -1; return; }
        if (hipOccupancyMaxActiveBlocksPerMultiprocessor(&per_cu, (const void*)fwd_megakernel, NTHREADS, LDS_BYTES) != hipSuccess || per_cu < 1) { fprintf(stderr, "kernel_launch: occupancy query gave %d\n", per_cu); per_cu = 1; }
        (void)hipGetLastError();
        grid = cus * per_cu;
    }
    if (grid < 0) return;
    Args a{};
    for (int i = 0; i < 23; ++i) a.in[i] = d_in[i];
    a.out = (float*)d_out; a.ws = (unsigned char*)d_ws;
#if MULTI_LAUNCH
    for (int ph = 0; ph < NPHASES; ++ph) { a.ph_lo = ph; a.ph_hi = ph + 1; hipLaunchKernelGGL(fwd_megakernel, dim3(grid), dim3(NTHREADS), LDS_BYTES, stream, a); }
#else
    a.ph_lo = 0; a.ph_hi = NPHASES;
    if (hipMemsetAsync((unsigned char*)d_ws + WS_CTL, 0, CTL_BYTES, stream) != hipSuccess) { fprintf(stderr, "kernel_launch: memset of the barrier words failed\n"); return; }
    void* args[] = {&a};
    hipError_t e = hipLaunchCooperativeKernel((const void*)fwd_megakernel, dim3(grid), dim3(NTHREADS), args, LDS_BYTES, stream);
    if (e != hipSuccess) fprintf(stderr, "cooperative launch failed: %s (grid %d)\n", hipGetErrorString(e), grid);
#endif
}
```

```cpp
#include <hip/hip_runtime.h>
#include <hip/hip_cooperative_groups.h>
#include <cstdio>
#include <cstdint>
namespace cg = cooperative_groups;
namespace pg8 {
#define PG8_LAS __attribute__((address_space(3)))
typedef unsigned short bf16_t;
typedef short bf16x8 __attribute__((ext_vector_type(8)));
typedef float f32x4 __attribute__((ext_vector_type(4)));
typedef unsigned u32x4 __attribute__((ext_vector_type(4)));
constexpr int BM = 256, BK = 64, HALF = 128, HTB = HALF * BK * 2  , STAGE_BYTES = 8 * HTB, NXCD = 8, WGM = 8;

__host__ __device__ __forceinline__ int lds_byte(int r, int c) { const int st = (r >> 4) * 2 + (c >> 5), rr = r & 15, cc = c & 31, ob = rr * 64 + cc * 2; return st * 1024 + (ob ^ (((ob >> 9) & 1) << 5)); }
__host__ __device__ __forceinline__ void stage_rc(int b, int& R, int& C) { const int st = b / 1024, sb = b % 1024, swz = sb ^ (((sb >> 9) & 1) << 5); R = (st >> 1) * 16 + swz / 64; C = (st & 1) * 32 + (swz % 64) / 2; }
__host__ __device__ __forceinline__ int perm32(int rho) { const int n = rho >> 4, i = rho & 15; return 8 * (i >> 2) + 4 * n + (i & 3); }

struct Unit { int pm, pn; };
struct Gemm { const bf16_t* A; const bf16_t* Bt; int M, N, K; };

struct StaticOrder {
    int nM, nN, nwg, G, c;
    __host__ __device__ void init(int M, int N, int G_, int c_) { nM = M / BM; nN = N / BM; nwg = nM * nN; G = G_; c = c_; }
    __host__ __device__ bool next(int i, Unit& u) const {
        const long L = (long)i * G + c; if (L >= nwg) return false;
        int wgid = (int)L; { const int q = nwg / NXCD, r = nwg % NXCD, xcd = wgid % NXCD, off = wgid / NXCD; wgid = (xcd < r ? xcd * (q + 1) : r * (q + 1) + (xcd - r) * q) + off; }
        const int nig = WGM * nN, gid = wgid / nig, fm = gid * WGM, gsz = (nM - fm) < WGM ? (nM - fm) : WGM;
        u.pm = fm + ((wgid % nig) % gsz); u.pn = (wgid % nig) / gsz; return true;
    }
    __device__ __forceinline__ void a_ready(const Unit&) const {}
    __device__ __forceinline__ void done(const Unit&) const {}
};

__device__ __forceinline__ unsigned cvt_pk_bf16(float lo, float hi) { unsigned r; asm volatile("v_cvt_pk_bf16_f32 %0, %1, %2" : "=v"(r) : "v"(lo), "v"(hi)); return r; }
typedef float f32x2 __attribute__((ext_vector_type(2)));
template <class Epi, class Sched, bool ALIGN_EPI = false, bool SP2 = false>
__device__ __forceinline__ void gemm_phase(PG8_LAS unsigned char* lds, const Gemm g, const Sched& S, const Epi& E) {
    const int tid = threadIdx.x, wid = __builtin_amdgcn_readfirstlane(tid >> 6), lane = tid & 63, wr = wid >> 2, wc = wid & 3, fr = lane & 15, fq = lane >> 4;
    const int K = g.K, nt = K / BK;
    unsigned voffA[2], voffB[2];
#pragma unroll
    for (int i = 0; i < 2; ++i) { int R, C; stage_rc(tid * 16 + i * 8192, R, C); const int Rb = Epi::PERM ? ((R & ~31) + perm32(R & 31)) : R;
        voffA[i] = (unsigned)(R * K + C) * 2u; voffB[i] = (unsigned)(Rb * K + C) * 2u; }
    const size_t kstep = (size_t)(BK * 2);
    const size_t hstep = (size_t)HALF * K * 2;
    const size_t tstep = 2 * hstep;
    const unsigned ldsw = (unsigned)wid * 1024u;
    const int aoff = lds_byte(wr * 64 + fr, fq * 8), boff = lds_byte(wc * 32 + fr, fq * 8);
#define PG8_SA(b, h) (((b) * 2 + (h)) * HTB)
#define PG8_SB(b, h) ((4 + (b) * 2 + (h)) * HTB)
#define PG8_STAGE(bufoff, gbase, voff) do { _Pragma("unroll") for (int _i = 0; _i < 2; ++_i) \
        __builtin_amdgcn_global_load_lds((const unsigned*)((const char*)(gbase) + (voff)[_i]), (PG8_LAS unsigned*)(lds + (bufoff) + ldsw + _i * 8192), 16, 0, 0); } while (0)
#define PG8_LDA(dst, b, h) do { _Pragma("unroll") for (int m = 0; m < 4; ++m) _Pragma("unroll") for (int k = 0; k < 2; ++k) dst[m][k] = *(const PG8_LAS bf16x8*)(lds + PG8_SA(b, h) + aoff + m * 2048 + k * 1024); } while (0)
#define PG8_LDB(dst, b, h) do { _Pragma("unroll") for (int n = 0; n < 2; ++n) _Pragma("unroll") for (int k = 0; k < 2; ++k) dst[n][k] = *(const PG8_LAS bf16x8*)(lds + PG8_SB(b, h) + boff + n * 2048 + k * 1024); } while (0)
#define PG8_MMA(ai, bj, At, Bt) do { __builtin_amdgcn_s_setprio(1); _Pragma("unroll") for (int m = 0; m < 4; ++m) _Pragma("unroll") for (int n = 0; n < 2; ++n) _Pragma("unroll") for (int k = 0; k < 2; ++k) \
        acc[ai][bj][m][n] = __builtin_amdgcn_mfma_f32_16x16x32_bf16(Bt[n][k], At[m][k], acc[ai][bj][m][n], 0, 0, 0); __builtin_amdgcn_s_setprio(0); } while (0)
#define PG8_WAIT_V(n) asm volatile("s_waitcnt vmcnt(" #n ")" ::: "memory")
#define PG8_WAIT_L(n) asm volatile("s_waitcnt lgkmcnt(" #n ")" ::: "memory")
#define PG8_BAR __builtin_amdgcn_s_barrier()
#define PG8_SCHED __builtin_amdgcn_sched_barrier(0)
    Unit cur, nxt; int ui = 0;
    if (!S.next(0, cur)) return;
    f32x4 acc[2][2][4][2];
#pragma unroll
    for (int a = 0; a < 2; ++a)
#pragma unroll
        for (int b = 0; b < 2; ++b)
#pragma unroll
            for (int m = 0; m < 4; ++m)
#pragma unroll
                for (int n = 0; n < 2; ++n) acc[a][b][m][n] = (f32x4){0.f, 0.f, 0.f, 0.f};
    bf16x8 At[4][2], B0[2][2], B1[2][2];
    const char* cA = (const char*)g.A + (size_t)cur.pm * tstep; const char* cB = (const char*)g.Bt + (size_t)cur.pn * tstep;
    S.a_ready(cur);
    if constexpr (SP2) {
        PG8_STAGE(PG8_SB(0, 0), cB, voffB); PG8_STAGE(PG8_SB(0, 1), cB + hstep, voffB); PG8_STAGE(PG8_SA(0, 0), cA, voffA); PG8_STAGE(PG8_SA(0, 1), cA + hstep, voffA);
        if (wr == 1) PG8_BAR;
        PG8_WAIT_V(2); PG8_BAR;
        PG8_STAGE(PG8_SB(1, 0), cB + kstep, voffB); PG8_STAGE(PG8_SA(1, 0), cA + kstep, voffA); PG8_STAGE(PG8_SB(1, 1), cB + hstep + kstep, voffB);
        PG8_WAIT_V(6); PG8_BAR;
    } else {
        PG8_STAGE(PG8_SB(0, 0), cB, voffB); PG8_STAGE(PG8_SA(0, 0), cA, voffA); PG8_STAGE(PG8_SB(0, 1), cB + hstep, voffB); PG8_STAGE(PG8_SA(0, 1), cA + hstep, voffA);
        if (wr == 1) PG8_BAR;
        PG8_WAIT_V(4); PG8_BAR;
        PG8_STAGE(PG8_SB(1, 0), cB + kstep, voffB); PG8_STAGE(PG8_SA(1, 0), cA + kstep, voffA); PG8_STAGE(PG8_SB(1, 1), cB + hstep + kstep, voffB);
        PG8_WAIT_V(6); PG8_BAR;
    }
    for (;;) {
        const bool has_next = S.next(ui + 1, nxt);
        const char* nA = has_next ? (const char*)g.A + (size_t)nxt.pm * tstep : cA; const char* nB = has_next ? (const char*)g.Bt + (size_t)nxt.pn * tstep : cB;
        for (int t = 0; t < nt; t += 2) {
            const bool last = (t == nt - 2);
            const char* a1 = cA + (size_t)(t + 1) * kstep;
            const char* a2 = last ? nA : cA + (size_t)(t + 2) * kstep; const char* b2 = last ? nB : cB + (size_t)(t + 2) * kstep;
            const char* a3 = a2 + kstep; const char* b3 = b2 + kstep;
            if (last && has_next) S.a_ready(nxt);
            if constexpr (SP2) {
            PG8_LDB(B0, 0, 0); PG8_LDB(B1, 0, 1); PG8_SCHED; PG8_LDA(At, 0, 0); PG8_STAGE(PG8_SA(1, 1), a1 + hstep, voffA);
            PG8_WAIT_V(8); PG8_WAIT_L(0); PG8_BAR; PG8_MMA(0, 0, At, B0); PG8_MMA(0, 1, At, B1); PG8_BAR; PG8_SCHED;
            PG8_LDA(At, 0, 1); PG8_STAGE(PG8_SB(0, 0), b2, voffB); PG8_STAGE(PG8_SB(0, 1), b2 + hstep, voffB); PG8_STAGE(PG8_SA(0, 0), a2, voffA);
            PG8_WAIT_V(8); PG8_WAIT_L(0); PG8_BAR; PG8_MMA(1, 0, At, B0); PG8_MMA(1, 1, At, B1); PG8_BAR; PG8_SCHED;
            PG8_LDB(B0, 1, 0); PG8_LDB(B1, 1, 1); PG8_SCHED; PG8_LDA(At, 1, 0); PG8_STAGE(PG8_SA(0, 1), a2 + hstep, voffA);
            PG8_WAIT_V(8); PG8_WAIT_L(0); PG8_BAR; PG8_MMA(0, 0, At, B0); PG8_MMA(0, 1, At, B1); PG8_BAR; PG8_SCHED;
            PG8_LDA(At, 1, 1); PG8_STAGE(PG8_SB(1, 0), b3, voffB); PG8_STAGE(PG8_SB(1, 1), b3 + hstep, voffB); PG8_STAGE(PG8_SA(1, 0), a3, voffA);
            PG8_WAIT_V(8); PG8_WAIT_L(0); PG8_BAR; PG8_MMA(1, 0, At, B0); PG8_MMA(1, 1, At, B1); PG8_BAR; PG8_SCHED;
            } else {
            PG8_LDB(B0, 0, 0); PG8_SCHED; PG8_LDA(At, 0, 0); PG8_STAGE(PG8_SA(1, 1), a1 + hstep, voffA);
            PG8_WAIT_L(8); PG8_BAR; PG8_WAIT_L(0); PG8_MMA(0, 0, At, B0); PG8_BAR; PG8_SCHED;
            PG8_LDB(B1, 0, 1); PG8_STAGE(PG8_SB(0, 0), b2, voffB);
            PG8_BAR; PG8_WAIT_L(0); PG8_MMA(0, 1, At, B1); PG8_BAR;
            PG8_LDA(At, 0, 1); PG8_STAGE(PG8_SA(0, 0), a2, voffA);
            PG8_BAR; PG8_WAIT_L(0); PG8_MMA(1, 0, At, B0); PG8_BAR; PG8_SCHED;
            PG8_STAGE(PG8_SB(0, 1), b2 + hstep, voffB);
            PG8_WAIT_V(6); PG8_BAR; PG8_MMA(1, 1, At, B1); PG8_BAR;
            PG8_LDB(B0, 1, 0); PG8_SCHED; PG8_LDA(At, 1, 0); PG8_STAGE(PG8_SA(0, 1), a2 + hstep, voffA);
            PG8_WAIT_L(8); PG8_BAR; PG8_WAIT_L(0); PG8_MMA(0, 0, At, B0); PG8_BAR; PG8_SCHED;
            PG8_LDB(B1, 1, 1); PG8_STAGE(PG8_SB(1, 0), b3, voffB);
            PG8_BAR; PG8_WAIT_L(0); PG8_MMA(0, 1, At, B1); PG8_BAR;
            PG8_LDA(At, 1, 1); PG8_STAGE(PG8_SA(1, 0), a3, voffA);
            PG8_BAR; PG8_WAIT_L(0); PG8_MMA(1, 0, At, B0); PG8_BAR; PG8_SCHED;
            PG8_STAGE(PG8_SB(1, 1), b3 + hstep, voffB);
            PG8_WAIT_V(6); PG8_BAR; PG8_MMA(1, 1, At, B1); PG8_BAR;
            }
        }
        if constexpr (ALIGN_EPI) { if (wr == 0) PG8_BAR; }
        if constexpr (!Epi::AFTER_DRAIN) { E(acc, cur, wr, wc, fr, fq); S.done(cur); }
        if (!has_next) break;
#pragma unroll
        for (int a = 0; a < 2; ++a)
#pragma unroll
            for (int b = 0; b < 2; ++b)
#pragma unroll
                for (int m = 0; m < 4; ++m)
#pragma unroll
                    for (int n = 0; n < 2; ++n) acc[a][b][m][n] = (f32x4){0.f, 0.f, 0.f, 0.f};
        cur = nxt; cA = nA; cB = nB; ++ui;
        if constexpr (ALIGN_EPI) { if (wr == 1) PG8_BAR; }
    }
    PG8_WAIT_V(0);
    if constexpr (!ALIGN_EPI) { if (wr == 0) PG8_BAR; }
    PG8_BAR;
    if constexpr (Epi::AFTER_DRAIN) { E.fused(acc, cur, wr, wc, fr, fq, lds, wid, lane); S.done(cur); }
#undef PG8_SA
#undef PG8_SB
#undef PG8_STAGE
#undef PG8_LDA
#undef PG8_LDB
#undef PG8_MMA
#undef PG8_WAIT_V
#undef PG8_WAIT_L
#undef PG8_BAR
#undef PG8_SCHED
}
}

#define LAS __attribute__((address_space(3)))
typedef unsigned short bf16;
typedef short bf16x8 __attribute__((ext_vector_type(8)));
typedef short s16x4 __attribute__((ext_vector_type(4)));
typedef float f32x4 __attribute__((ext_vector_type(4)));
typedef unsigned u32x4 __attribute__((ext_vector_type(4)));
typedef unsigned u32x2 __attribute__((ext_vector_type(2)));
using pg8::cvt_pk_bf16;

#ifndef MULTI_LAUNCH
#define MULTI_LAUNCH 0
#endif

constexpr int S = 8192, D = 2048, FF = 5632, NGU = 2 * FF, NCONV = 5120, NNSA = 2304, NNSA_SRC = 2084, NKV = 3072, CONVC = 1536;
constexpr int NMEM = 256, MEMKVW = 1024, QW = 1536;
constexpr int NTHREADS = 512, NWAVES = 8, LDS_BYTES = 131072 + 2048 + 256;
constexpr int NPHASES = 22;

constexpr size_t al256(size_t x) { return (x + 255) & ~(size_t)255; }
constexpr size_t SZ_WGU = (size_t)NGU * D * 2, SZ_WD = (size_t)D * FF * 2;
constexpr size_t WS_WGU = 0;
constexpr size_t WS_WD = WS_WGU + 4 * SZ_WGU;
constexpr size_t WS_WCONV = WS_WD + 4 * SZ_WD;
constexpr size_t WS_WNSA = WS_WCONV + (size_t)NCONV * D * 2;
constexpr size_t WS_WOUT = WS_WNSA + (size_t)NNSA * D * 2;
constexpr size_t WS_WKV = WS_WOUT + 2 * (size_t)D * D * 2;
constexpr size_t WS_WMEM = WS_WKV + (size_t)NKV * D * 2;
constexpr size_t WS_W1C = WS_WMEM + 2 * (size_t)MEMKVW * D * 2;
constexpr size_t WS_W2C = WS_W1C + 2 * (size_t)128 * 4096 * 2;
constexpr size_t WS_H = WS_W2C + 2 * (size_t)128 * 128 * 2;
constexpr size_t WS_XN = WS_H + (size_t)S * D * 4;
constexpr size_t WS_XKV = WS_XN + (size_t)S * D * 2;
constexpr size_t WS_ACT = WS_XKV + (size_t)S * D * 2;
constexpr size_t WS_UCONV = WS_ACT;
constexpr size_t WS_UNSA = WS_ACT;
constexpr size_t WS_TMP = WS_ACT + (size_t)S * NNSA * 2;
constexpr size_t WS_UKV = WS_ACT + (size_t)S * FF * 2;
constexpr size_t WS_CAT = WS_UKV + (size_t)S * NKV * 2;
constexpr size_t WS_KCR = WS_CAT + (size_t)S * D * 2;
constexpr size_t SZ_KR = (size_t)4 * S * 128 * 2, SLACK = 16 * 128 * 2;
constexpr size_t WS_VCR = WS_KCR + SZ_KR + SLACK;
constexpr size_t WS_KSR = WS_VCR + SZ_KR + SLACK;
constexpr size_t WS_KWR = WS_KSR + SZ_KR;
constexpr size_t WS_KCC = WS_KWR + SZ_KR;
constexpr size_t WS_VCC = WS_KCC + (size_t)4 * 512 * 128 * 2;
constexpr size_t WS_MEMN = WS_VCC + (size_t)4 * 512 * 128 * 2;
constexpr size_t WS_MEMKV = WS_MEMN + 2 * (size_t)NMEM * D * 2;
constexpr size_t WS_ROPE = WS_MEMKV + 2 * (size_t)NMEM * MEMKVW * 2;
constexpr size_t WS_SELB = WS_ROPE + (size_t)S * 32 * 4;
constexpr size_t WS_SS = WS_SELB + (size_t)S * 4 * 4 * 4;
constexpr size_t WS_CTL = WS_SS + (size_t)5 * S * 4;
constexpr size_t CTL_BYTES = 16384;
constexpr size_t WS_END = WS_CTL + CTL_BYTES;
static_assert((size_t)S * NNSA * 2 + (size_t)S * QW * 4 <= (size_t)S * FF * 2, "overlay fits in ACT");
static_assert((size_t)S * NCONV * 2 <= (size_t)S * FF * 2, "overlay fits in ACT");
static_assert(WS_END <= (size_t)4 * 2 * 2 * 2048 * 5632 * 4, "workspace must fit the guaranteed size");

struct Args { const void* in[23]; float* out; unsigned char* ws; int ph_lo, ph_hi; };

struct Ctx { LAS unsigned char* lds; int tid, lane, wid, G, bid; };

__device__ __forceinline__ float bf2f(unsigned short b) { return __uint_as_float(((unsigned)b) << 16); }
__device__ __forceinline__ float bflo(unsigned w) { return __uint_as_float(w << 16); }
__device__ __forceinline__ float bfhi(unsigned w) { return __uint_as_float(w & 0xffff0000u); }
__device__ __forceinline__ float wave_sum(float v) {
#pragma unroll
    for (int o = 1; o < 64; o <<= 1) v += __shfl_xor(v, o);
    return v;
}
__device__ __forceinline__ float fexp2(float x) { return __builtin_amdgcn_exp2f(x); }

__device__ __forceinline__ float rstd_of(const float* ss, int row) { return ss ? 1.0f / sqrtf(ss[row] * (1.0f / D) + 1e-6f) : 1.0f; }
struct EpiPlain {
    static constexpr bool PERM = true, AFTER_DRAIN = false;
    bf16* O; int ldc; const float* ss = nullptr;
    __device__ __forceinline__ void operator()(const f32x4 (&acc)[2][2][4][2], const pg8::Unit& u, int wr, int wc, int fr, int fq) const {
        const int row0 = u.pm * 256 + wr * 64 + fr, col0 = u.pn * 256 + wc * 32 + 8 * fq;
#pragma unroll
        for (int ai = 0; ai < 2; ++ai)
#pragma unroll
            for (int m = 0; m < 4; ++m) { const int row = row0 + ai * 128 + m * 16; bf16* rowp = O + (size_t)row * ldc + col0; const float rs = rstd_of(ss, row);
#pragma unroll
                for (int bj = 0; bj < 2; ++bj) { const f32x4 v0 = acc[ai][bj][m][0] * rs, v1 = acc[ai][bj][m][1] * rs;
                    u32x4 w; w.x = cvt_pk_bf16(v0[0], v0[1]); w.y = cvt_pk_bf16(v0[2], v0[3]); w.z = cvt_pk_bf16(v1[0], v1[1]); w.w = cvt_pk_bf16(v1[2], v1[3]);
                    *(u32x4*)(rowp + bj * 128) = w; } }
    }
};
__device__ __forceinline__ float silu_mul(float g, float u) { return g * __builtin_amdgcn_rcpf(1.0f + fexp2(-1.4426950408889634f * g)) * u; }
struct EpiSwiGLU {
    static constexpr bool PERM = true, AFTER_DRAIN = false;
    bf16* O; int ldc; const float* ss = nullptr;
    __device__ __forceinline__ void operator()(const f32x4 (&acc)[2][2][4][2], const pg8::Unit& u, int wr, int wc, int fr, int fq) const {
        const int row0 = u.pm * 256 + wr * 64 + fr, col0 = u.pn * 128 + wc * 32 + 8 * fq;
#pragma unroll
        for (int ai = 0; ai < 2; ++ai)
#pragma unroll
            for (int m = 0; m < 4; ++m) { const int row = row0 + ai * 128 + m * 16; bf16* rowp = O + (size_t)row * ldc + col0; const float rs = rstd_of(ss, row);
                const f32x4 g0 = acc[ai][0][m][0] * rs, g1 = acc[ai][0][m][1] * rs, u0 = acc[ai][1][m][0] * rs, u1 = acc[ai][1][m][1] * rs;
                u32x4 w;
                w.x = cvt_pk_bf16(silu_mul(g0[0], u0[0]), silu_mul(g0[1], u0[1])); w.y = cvt_pk_bf16(silu_mul(g0[2], u0[2]), silu_mul(g0[3], u0[3]));
                w.z = cvt_pk_bf16(silu_mul(g1[0], u1[0]), silu_mul(g1[1], u1[1])); w.w = cvt_pk_bf16(silu_mul(g1[2], u1[2]), silu_mul(g1[3], u1[3]));
                *(u32x4*)rowp = w; }
    }
};
struct EpiRes {
    static constexpr bool PERM = true, AFTER_DRAIN = false;
    const float* base; float* out; int ldc; float alpha;
    float* ss = nullptr; bf16* o1 = nullptr;
    __device__ __forceinline__ void operator()(const f32x4 (&acc)[2][2][4][2], const pg8::Unit& u, int wr, int wc, int fr, int fq) const {
        const int row0 = u.pm * 256 + wr * 64 + fr, col0 = u.pn * 256 + wc * 32 + 8 * fq;
#pragma unroll
        for (int ai = 0; ai < 2; ++ai)
#pragma unroll
            for (int m = 0; m < 4; ++m) { const int row = row0 + ai * 128 + m * 16; const size_t off = (size_t)row * ldc + col0; float sq = 0.f;
#pragma unroll
                for (int bj = 0; bj < 2; ++bj) { const int co = bj * 128;
                    const f32x4 b0 = *(const f32x4*)(base + off + co), b1 = *(const f32x4*)(base + off + co + 4);
                    const f32x4 v0 = b0 + alpha * acc[ai][bj][m][0], v1 = b1 + alpha * acc[ai][bj][m][1];
                    *(f32x4*)(out + off + co) = v0; *(f32x4*)(out + off + co + 4) = v1;
                    if (ss) { sq += ((v0.x * v0.x + v0.y * v0.y) + (v0.z * v0.z + v0.w * v0.w)) + ((v1.x * v1.x + v1.y * v1.y) + (v1.z * v1.z + v1.w * v1.w));
                        u32x4 w; w.x = cvt_pk_bf16(v0.x, v0.y); w.y = cvt_pk_bf16(v0.z, v0.w); w.z = cvt_pk_bf16(v1.x, v1.y); w.w = cvt_pk_bf16(v1.z, v1.w); *(u32x4*)(o1 + off + co) = w; } }
                if (ss) { sq += __shfl_xor(sq, 16); sq += __shfl_xor(sq, 32); if (fq == 0) atomicAdd(ss + row, sq); } }
    }
};

template <class Epi>
__device__ __forceinline__ void run_gemm(const Ctx& c, const bf16* A, const bf16* Bt, int M, int N, int K, const Epi& E, int cidx) {
    pg8::Gemm g{A, Bt, M, N, K}; pg8::StaticOrder So; So.init(M, N, c.G, cidx);
    pg8::gemm_phase<Epi, pg8::StaticOrder, true, true>(c.lds, g, So, E);
}

struct Seg { const float* src; bf16* dst; int K, N, c0, nc, d0, mode; const float* gk; };
constexpr int NSEG = 25;
__device__ __forceinline__ Seg get_seg(const Args& a, int id) {
    Seg s; unsigned char* ws = a.ws; s.c0 = 0; s.d0 = 0; s.mode = 0; s.gk = nullptr;
    if (id < 12) { const int f = id / 3, kind = id - 3 * f;
        if (kind == 0) { s.src = (const float*)a.in[4] + (size_t)f * D * FF; s.dst = (bf16*)(ws + WS_WGU + f * SZ_WGU); s.K = D; s.N = FF; s.nc = FF; s.mode = 1; if (f > 0) s.gk = (const float*)a.in[3] + (size_t)f * D; }
        else if (kind == 1) { s.src = (const float*)a.in[5] + (size_t)f * D * FF; s.dst = (bf16*)(ws + WS_WGU + f * SZ_WGU); s.K = D; s.N = FF; s.nc = FF; s.mode = 1; s.d0 = 128; if (f > 0) s.gk = (const float*)a.in[3] + (size_t)f * D; }
        else { s.src = (const float*)a.in[6] + (size_t)f * FF * D; s.dst = (bf16*)(ws + WS_WD + f * SZ_WD); s.K = FF; s.N = D; s.nc = D; }
    } else if (id == 12) { s.src = (const float*)a.in[11]; s.dst = (bf16*)(ws + WS_WCONV); s.K = D; s.N = NCONV; s.nc = NCONV; s.gk = (const float*)a.in[7]; }
    else if (id == 13) { s.src = (const float*)a.in[13]; s.dst = (bf16*)(ws + WS_WNSA); s.K = D; s.N = NNSA_SRC; s.c0 = 0; s.nc = 1536; s.d0 = 0; s.gk = (const float*)a.in[7] + D; }
    else if (id == 14) { s.src = (const float*)a.in[13]; s.dst = (bf16*)(ws + WS_WNSA); s.K = D; s.N = NNSA_SRC; s.c0 = 1536; s.nc = 36; s.d0 = 2048; s.gk = (const float*)a.in[7] + D; }
    else if (id == 15) { s.src = (const float*)a.in[13]; s.dst = (bf16*)(ws + WS_WNSA); s.K = D; s.N = NNSA_SRC; s.c0 = 1572; s.nc = 512; s.d0 = 1536; s.gk = (const float*)a.in[7] + D; }
    else if (id <= 17) { const int l = id - 16; s.src = (const float*)a.in[10] + (size_t)l * D * D; s.dst = (bf16*)(ws + WS_WOUT + (size_t)l * D * D * 2); s.K = D; s.N = D; s.nc = D; }
    else if (id == 18) { s.src = (const float*)a.in[15]; s.dst = (bf16*)(ws + WS_WKV); s.K = D; s.N = NKV; s.nc = NKV; s.gk = (const float*)a.in[14]; }
    else if (id <= 20) { const int l = id - 19; s.src = (const float*)a.in[9] + (size_t)l * D * MEMKVW; s.dst = (bf16*)(ws + WS_WMEM + (size_t)l * MEMKVW * D * 2); s.K = D; s.N = MEMKVW; s.nc = MEMKVW; }
    else if (id <= 22) { const int w = id - 21; s.src = (const float*)a.in[w ? 20 : 17]; s.dst = (bf16*)(ws + WS_W1C + (size_t)w * 128 * 4096 * 2); s.K = 4096; s.N = 128; s.nc = 128; }
    else { const int w = id - 23; s.src = (const float*)a.in[w ? 21 : 18]; s.dst = (bf16*)(ws + WS_W2C + (size_t)w * 128 * 128 * 2); s.K = 128; s.N = 128; s.nc = 128; }
    return s;
}
__device__ __forceinline__ void transpose_item(const Seg& s, LAS float* scr, int item, int lane) {
    const int nblk = (s.nc + 31) >> 5, kb = item / nblk, nb = item - kb * nblk, k0 = 64 * kb, cb = 32 * nb;
    const int cl = cb + (lane & 31); const bool cok = cl < s.nc;
    const float* sp = s.src + (size_t)(k0 + (lane >> 5)) * s.N + s.c0 + cl;
    float tv[32];
#pragma unroll
    for (int i = 0; i < 32; ++i) tv[i] = cok ? __builtin_nontemporal_load(sp + (size_t)(2 * i) * s.N) : 0.f;
    if (s.gk) {
#pragma unroll
        for (int i = 0; i < 32; ++i) tv[i] *= s.gk[k0 + 2 * i + (lane >> 5)];
    }
#pragma unroll
    for (int i = 0; i < 32; ++i) scr[(2 * i + (lane >> 5)) * 33 + (lane & 31)] = tv[i];
    asm volatile("s_waitcnt lgkmcnt(0)" ::: "memory");
    const int c8 = lane & 7;
#pragma unroll
    for (int j = 0; j < 4; ++j) { const int n = (lane >> 3) + 8 * j; const int c = cb + n; const LAS float* q = scr + (8 * c8) * 33 + n;
        u32x4 o; o.x = cvt_pk_bf16(q[0 * 33], q[1 * 33]); o.y = cvt_pk_bf16(q[2 * 33], q[3 * 33]); o.z = cvt_pk_bf16(q[4 * 33], q[5 * 33]); o.w = cvt_pk_bf16(q[6 * 33], q[7 * 33]);
        const int drow = s.d0 + (s.mode ? ((c >> 7) * 256 + (c & 127)) : c);
        if (c < s.nc) *(u32x4*)(s.dst + (size_t)drow * s.K + k0 + 8 * c8) = o; }
    asm volatile("s_waitcnt lgkmcnt(0)" ::: "memory");
}

__device__ __forceinline__ void rms_row(const float* xrow, const float* g1, bf16* o1, const float* g2, bf16* o2, float* of, int lane) {
    const f32x4* xr = (const f32x4*)xrow + lane;
    f32x4 v[8]; float s = 0.f;
#pragma unroll
    for (int j = 0; j < 8; ++j) { v[j] = xr[64 * j]; s += (v[j].x * v[j].x + v[j].y * v[j].y) + (v[j].z * v[j].z + v[j].w * v[j].w); }
    const float rstd = 1.0f / sqrtf(wave_sum(s) * (1.0f / D) + 1e-6f);
#pragma unroll
    for (int j = 0; j < 8; ++j) { const f32x4 y = v[j] * rstd; const f32x4 ga = ((const f32x4*)g1)[lane + 64 * j]; const f32x4 a = y * ga;
        if (o1) { u32x2 w; w.x = cvt_pk_bf16(a.x, a.y); w.y = cvt_pk_bf16(a.z, a.w); ((u32x2*)o1)[lane + 64 * j] = w; }
        if (of) ((f32x4*)of)[lane + 64 * j] = a;
        if (o2) { const f32x4 gb = ((const f32x4*)g2)[lane + 64 * j]; const f32x4 b = y * gb; u32x2 w; w.x = cvt_pk_bf16(b.x, b.y); w.y = cvt_pk_bf16(b.z, b.w); ((u32x2*)o2)[lane + 64 * j] = w; } }
}
__device__ __forceinline__ void norm_rows(const Ctx& c, const float* src, int nrows, const float* g1, bf16* o1, const float* g2, bf16* o2, float* of) {
    const int gw = c.bid * NWAVES + c.wid, NGW = c.G * NWAVES;
    for (int r = gw; r < nrows; r += NGW) rms_row(src + (size_t)r * D, g1, o1 ? o1 + (size_t)r * D : nullptr, g2, o2 ? o2 + (size_t)r * D : nullptr, of ? of + (size_t)r * D : nullptr, c.lane);
}

__device__ __forceinline__ void convert_segs(const Ctx& c, const Args& a, unsigned mask, int widx, int nwork) {
    LAS float* scr = (LAS float*)(c.lds + c.wid * 16384);
    const int gw = widx * NWAVES + c.wid, NGW = nwork * NWAVES;
    int base = 0;
    for (int sid = 0; sid < NSEG; ++sid) {
        if (!((mask >> sid) & 1u)) continue;
        const Seg s = get_seg(a, sid);
        const int n = (s.K >> 6) * ((s.nc + 31) >> 5);
        int first = (gw - base) % NGW; if (first < 0) first += NGW;
        for (int it = first; it < n; it += NGW) transpose_item(s, scr, it, c.lane);
        base = (base + n) % NGW;
    }
}
constexpr unsigned SEGM(int i) { return 1u << i; }
constexpr unsigned CV_ALL = (1u << NSEG) - 1u;
constexpr unsigned CV_P1 = SEGM(2) | SEGM(12);
constexpr unsigned CV_P4 = SEGM(16) | SEGM(3) | SEGM(4);
constexpr unsigned CV_P8 = SEGM(5) | SEGM(13) | SEGM(14) | SEGM(15) | SEGM(21) | SEGM(22) | SEGM(23) | SEGM(24) | SEGM(17);
constexpr unsigned CV_P14 = SEGM(9) | SEGM(10);
constexpr unsigned CV_P19 = SEGM(11);
constexpr unsigned CV_P0 = CV_ALL & ~(CV_P1 | CV_P4 | CV_P8 | CV_P14 | CV_P19);
__device__ __forceinline__ void prologue(const Ctx& c, const Args& a) {
    convert_segs(c, a, (c.G == 256) ? CV_P0 : CV_ALL, c.bid, c.G);
    const int gw = c.bid * NWAVES + c.wid, NGW = c.G * NWAVES;
    norm_rows(c, (const float*)a.in[0], S, (const float*)a.in[3], (bf16*)(a.ws + WS_XN), nullptr, nullptr, nullptr);
    norm_rows(c, (const float*)a.in[1], NMEM, (const float*)a.in[8], (bf16*)(a.ws + WS_MEMN), (const float*)a.in[8] + D, (bf16*)(a.ws + WS_MEMN + (size_t)NMEM * D * 2), nullptr);
    const int* pos = (const int*)a.in[2]; float* rope = (float*)(a.ws + WS_ROPE);
    for (int i = c.bid * NTHREADS + c.tid; i < S * 16; i += c.G * NTHREADS) { const int t = i >> 4, f = i & 15;
        const double inv = pow(500000.0, -(double)f / 16.0);
        const double ang = (double)pos[t] * inv; rope[t * 32 + f] = (float)cos(ang); rope[t * 32 + 16 + f] = (float)sin(ang); }
    for (int i = c.bid * NTHREADS + c.tid; i < 5 * S; i += c.G * NTHREADS) ((float*)(a.ws + WS_SS))[i] = 0.f;
    for (int i = c.bid * NTHREADS + c.tid; i < 2 * 2048; i += c.G * NTHREADS) { bf16* p = (bf16*)(a.ws + (i < 2048 ? WS_KCR : WS_VCR) + SZ_KR); p[i & 2047] = 0; }
}

typedef short v4i16_t __attribute__((ext_vector_type(4)));
__device__ __forceinline__ s16x4 vtr(LAS const unsigned char* p) { return __builtin_bit_cast(s16x4, __builtin_amdgcn_ds_read_tr16_b64_v4i16((LAS v4i16_t*)p)); }
__device__ __forceinline__ unsigned xr_of(unsigned row) { return ((row & 3u) << 2) | ((row >> 2) & 3u); }
constexpr int KV_BUF = 32768;
constexpr int IMP_OFF = 65536;
constexpr float C1 = 0.08838834764831845f * 1.4426950408889634f;

__device__ __forceinline__ void stage_kv(LAS unsigned char* buf, const bf16* Kg, int ldk, const bf16* Vg, int ldv, int key0, int wid, int lane_in) {
    int lane = lane_in; asm volatile("" : "+v"(lane));
#pragma unroll
    for (int i = 0; i < 2; ++i) {
        const unsigned b = (unsigned)(i * 8192 + wid * 1024 + lane * 16); const unsigned row = b >> 8, pos = (b >> 4) & 15u; const unsigned ch = pos ^ xr_of(row);
        const unsigned chv = pos ^ (2u * (row & 7u));
        __builtin_amdgcn_global_load_lds((const unsigned*)(Kg + (size_t)(key0 + (int)row) * ldk + ch * 8), (LAS unsigned*)(buf + i * 8192 + wid * 1024), 16, 0, 0);
        __builtin_amdgcn_global_load_lds((const unsigned*)(Vg + (size_t)(key0 + (int)row) * ldv + chv * 8), (LAS unsigned*)(buf + 16384 + i * 8192 + wid * 1024), 16, 0, 0);
    }
}

__device__ __forceinline__ float gmax4(float x) { auto a = __builtin_amdgcn_permlane16_swap(__float_as_uint(x), __float_as_uint(x), false, false); x = fmaxf(__uint_as_float(a[0]), __uint_as_float(a[1]));
    auto b = __builtin_amdgcn_permlane32_swap(__float_as_uint(x), __float_as_uint(x), false, false); return fmaxf(__uint_as_float(b[0]), __uint_as_float(b[1])); }
__device__ __forceinline__ float gsum4(float x) { auto a = __builtin_amdgcn_permlane16_swap(__float_as_uint(x), __float_as_uint(x), false, false); x = __uint_as_float(a[0]) + __uint_as_float(a[1]);
    auto b = __builtin_amdgcn_permlane32_swap(__float_as_uint(x), __float_as_uint(x), false, false); return __uint_as_float(b[0]) + __uint_as_float(b[1]); }
struct AX { float linv[3]; float tc; LAS float* impw; bool first; unsigned sel[4]; };

template <int NH, int MODE, bool EMASK, int QS>
__device__ __forceinline__ void attn_tile(LAS const unsigned char* kbuf, LAS const unsigned char* vbuf, const bf16x8 (&Q)[NH][4], f32x4 (&O)[NH][8], float (&m)[NH], float (&l)[NH],
                                          int key0, int T, int t, int lane_in, unsigned csel, AX& ax) {
    constexpr int HV = (NH > 1) ? 2 : 1, KBN = 4 / HV, CN = 2 / HV;
    int lane = lane_in; asm volatile("" : "+v"(lane));
    const int g = lane >> 4, r = lane & 15;
    const unsigned xr = xr_of((unsigned)r);
    const unsigned kbase = 256u * (unsigned)r + 16u * ((unsigned)g ^ (xr & 3u)), xs = xr >> 2;
    const unsigned q = (unsigned)r >> 2, pp = (unsigned)r & 3u;
    const unsigned wv = 4u * ((unsigned)g & 1u) + q;
    const unsigned vrow = 256u * (4u * (unsigned)g + q) + 8u * (pp & 1u) + 16u * (pp >> 1);
    const float NEG = -__builtin_inff();
    float prevc = ax.tc;
#pragma unroll
    for (int hf = 0; hf < HV; ++hf) {
        f32x4 sacc[NH][KBN];
#pragma unroll
        for (int h = 0; h < NH; ++h)
#pragma unroll
            for (int kbl = 0; kbl < KBN; ++kbl) sacc[h][kbl] = (f32x4){0.f, 0.f, 0.f, 0.f};
#pragma unroll
        for (int kbl = 0; kbl < KBN; ++kbl) {
            bf16x8 kf[4];
#pragma unroll
            for (int s = 0; s < 4; ++s) kf[s] = *(LAS const bf16x8*)(kbuf + kbase + 4096u * (hf * KBN + kbl) + 64u * ((unsigned)s ^ xs));
            __builtin_amdgcn_s_setprio(1);
#pragma unroll
            for (int s = 0; s < 4; ++s)
#pragma unroll
                for (int h = 0; h < NH; ++h) sacc[h][kbl] = __builtin_amdgcn_mfma_f32_16x16x32_bf16(kf[s], Q[h][s], sacc[h][kbl], 0, 0, 0);
            __builtin_amdgcn_s_setprio(0);
            if (NH > 1) __builtin_amdgcn_sched_barrier(0);
        }
        bf16x8 pk[NH][CN];
        float mainh[KBN], carh[KBN];
#pragma unroll
        for (int kbl = 0; kbl < KBN; ++kbl) { mainh[kbl] = 0.f; carh[kbl] = 0.f; }
#pragma unroll
        for (int h = 0; h < NH; ++h) {
            const int th = t + QS * h;
            int hi_lim = 1 << 20, lo_lim = -(1 << 20);
            if (MODE == 0 || MODE == 1) hi_lim = ((th - 31) >> 4) - key0 - 4 * g;
            if (MODE == 2 || MODE == 3) hi_lim = th - key0 - 4 * g;
            if (MODE == 3) lo_lim = th - 512 - key0 - 4 * g;
            const float bias = (MODE == 2 && !((csel >> h) & 1u)) ? NEG : 0.f;
            float x[KBN][4]; float mx = NEG;
#pragma unroll
            for (int kbl = 0; kbl < KBN; ++kbl)
#pragma unroll
                for (int i = 0; i < 4; ++i) {
                    float v = sacc[h][kbl][i];
                    if (EMASK) { const int e = 16 * (hf * KBN + kbl) + i; const bool valid = (MODE == 3) ? (e <= hi_lim && e > lo_lim) : (e <= hi_lim); v = valid ? v : NEG; }
                    x[kbl][i] = v; mx = fmaxf(mx, v);
                }
            float p[KBN][4];
            if (MODE == 1) {
                const float nmu = -m[h], li = ax.linv[h];
#pragma unroll
                for (int kbl = 0; kbl < KBN; ++kbl) {
#pragma unroll
                    for (int i = 0; i < 4; ++i) p[kbl][i] = fexp2(fmaf(x[kbl][i], C1, nmu)) * li;
                    mainh[kbl] += (p[kbl][0] + p[kbl][1]) + (p[kbl][2] + 0.5f * p[kbl][3]); carh[kbl] += 0.5f * p[kbl][3];
                }
            } else {
                mx = gmax4(mx);
                mx = mx * C1 + bias;
                const float mn = fmaxf(m[h], mx); const float mu = (mn == NEG) ? 0.f : mn;
                const float alpha = fexp2(m[h] - mu); const float nb_ = bias - mu;
                float ps = 0.f;
#pragma unroll
                for (int kbl = 0; kbl < KBN; ++kbl)
#pragma unroll
                    for (int i = 0; i < 4; ++i) { p[kbl][i] = fexp2(fmaf(x[kbl][i], C1, nb_)); ps += p[kbl][i]; }
                l[h] = l[h] * alpha + ps; m[h] = mn;
                if (MODE != 0) {
                    if (__ballot(alpha != 1.0f) != 0ull) {
#pragma unroll
                        for (int db = 0; db < 8; ++db) O[h][db] = O[h][db] * alpha;
                    }
                }
            }
            if (MODE != 0) {
#pragma unroll
                for (int cl = 0; cl < CN; ++cl) {
                    u32x4 w; w.x = cvt_pk_bf16(p[2 * cl][0], p[2 * cl][1]); w.y = cvt_pk_bf16(p[2 * cl][2], p[2 * cl][3]);
                    w.z = cvt_pk_bf16(p[2 * cl + 1][0], p[2 * cl + 1][1]); w.w = cvt_pk_bf16(p[2 * cl + 1][2], p[2 * cl + 1][3]);
                    pk[h][cl] = __builtin_bit_cast(bf16x8, w);
                }
            }
        }
        if (MODE == 1) {
#pragma unroll
            for (int kbl = 0; kbl < KBN; ++kbl) {
                const float a = __shfl(carh[kbl], (lane - 16) & 63);
                const float b = __shfl(prevc, (lane + 48) & 63);
                const float cp = (g == 0) ? b : a;
                { LAS float* ip = ax.impw + r * 128 + 16 * T + 4 * (hf * KBN + kbl) + g; const float nv = mainh[kbl] + cp; *ip = ax.first ? nv : (*ip + nv); }
                prevc = carh[kbl];
            }
        }
        if (MODE != 0) {
#pragma unroll
            for (int cl = 0; cl < CN; ++cl)
#pragma unroll
                for (int db = 0; db < 8; ++db) {
                    const int cc = hf * CN + cl;
                    const unsigned cho = 32u * ((unsigned)db ^ wv);
                    const s16x4 v0 = vtr(vbuf + vrow + 4096u * (2 * cc) + cho), v1 = vtr(vbuf + vrow + 4096u * (2 * cc + 1) + cho);
                    const bf16x8 vf = {v0[0], v0[1], v0[2], v0[3], v1[0], v1[1], v1[2], v1[3]};
#pragma unroll
                    for (int h = 0; h < NH; ++h) O[h][db] = __builtin_amdgcn_mfma_f32_16x16x32_bf16(vf, pk[h][cl], O[h][db], 0, 0, 0);
                    if (NH > 1 && (db & 3) == 3) __builtin_amdgcn_sched_barrier(0);
                }
        }
    }
    if (MODE == 1) ax.tc = prevc;
}

template <int NH, int MODE>
__device__ __forceinline__ void attn_run(const Ctx& c, const bf16* Kg, int ldk, const bf16* Vg, int ldv, int tile_lo, int tile_hi,
                                         const bf16x8 (&Q)[NH][4], f32x4 (&O)[NH][8], float (&m)[NH], float (&l)[NH], int t, AX& ax) {
    if (tile_lo >= tile_hi) return;
    const int q_lo = __builtin_amdgcn_readfirstlane(t) & ~127;
    constexpr int NBUF = (MODE == 0 || MODE == 1) ? 2 : 4, DIST = NBUF - 1;
    __syncthreads();
#pragma unroll
    for (int d = 0; d < DIST; ++d) if (tile_lo + d < tile_hi) stage_kv(c.lds + d * KV_BUF, Kg, ldk, Vg, ldv, 64 * (tile_lo + d), c.wid, c.lane);
    for (int T = tile_lo; T < tile_hi; ++T) {
        const int cur = (T - tile_lo) & (NBUF - 1);
        if (DIST > 1 && T + DIST - 1 < tile_hi) { if (DIST == 3) asm volatile("s_waitcnt vmcnt(8)" ::: "memory"); else asm volatile("s_waitcnt vmcnt(4)" ::: "memory"); }
        else asm volatile("s_waitcnt vmcnt(0)" ::: "memory");
        __syncthreads();
        if (T + DIST < tile_hi) stage_kv(c.lds + ((T - tile_lo + DIST) & (NBUF - 1)) * KV_BUF, Kg, ldk, Vg, ldv, 64 * (T + DIST), c.wid, c.lane);
        bool colsel = true; bool doit = true;
        if (MODE == 2) {
            const int w = T >> 5; const unsigned word = (w == 0) ? ax.sel[0] : (w == 1) ? ax.sel[1] : (w == 2) ? ax.sel[2] : ax.sel[3];
            colsel = ((word >> (T & 31)) & 1u) != 0u;
            doit = __ballot(colsel) != 0ull;
        }
        bool em = false;
        if (MODE == 0 || MODE == 1) em = (1024 * T + 1039 > q_lo);
        if (MODE == 2) em = (64 * T + 63 > q_lo);
        if (MODE == 3) em = (64 * T + 63 > q_lo) || (64 * T <= q_lo + 127 - 512);
        if (doit) {
            if (em) attn_tile<NH, MODE, true, 0>(c.lds + cur * KV_BUF, c.lds + cur * KV_BUF + 16384, Q, O, m, l, 64 * T, T, t, c.lane, colsel ? 0xffu : 0u, ax);
            else attn_tile<NH, MODE, false, 0>(c.lds + cur * KV_BUF, c.lds + cur * KV_BUF + 16384, Q, O, m, l, 64 * T, T, t, c.lane, colsel ? 0xffu : 0u, ax);
        }
    }
}

__device__ __forceinline__ void load_q(bf16x8 (&Qh)[4], const bf16* rowp, const float* rope_t, int lane) {
    const int g = lane >> 4;
#pragma unroll
    for (int s = 0; s < 4; ++s) Qh[s] = *(const bf16x8*)(rowp + 32 * s + 8 * g);
    if (rope_t) {
        const u32x4 own = __builtin_bit_cast(u32x4, Qh[0]); u32x4 par;
        par.x = __shfl_xor(own.x, 32); par.y = __shfl_xor(own.y, 32); par.z = __shfl_xor(own.z, 32); par.w = __shfl_xor(own.w, 32);
        const int f0 = 8 * (g & 1);
        const f32x4 c0 = *(const f32x4*)(rope_t + f0), c1 = *(const f32x4*)(rope_t + f0 + 4), s0 = *(const f32x4*)(rope_t + 16 + f0), s1 = *(const f32x4*)(rope_t + 16 + f0 + 4);
        const float sg = (g < 2) ? -1.f : 1.f;
        const float o0 = bflo(own.x) * c0.x + sg * bflo(par.x) * s0.x, o1 = bfhi(own.x) * c0.y + sg * bfhi(par.x) * s0.y;
        const float o2 = bflo(own.y) * c0.z + sg * bflo(par.y) * s0.z, o3 = bfhi(own.y) * c0.w + sg * bfhi(par.y) * s0.w;
        const float o4 = bflo(own.z) * c1.x + sg * bflo(par.z) * s1.x, o5 = bfhi(own.z) * c1.y + sg * bfhi(par.z) * s1.y;
        const float o6 = bflo(own.w) * c1.z + sg * bflo(par.w) * s1.z, o7 = bfhi(own.w) * c1.w + sg * bfhi(par.w) * s1.w;
        u32x4 w; w.x = cvt_pk_bf16(o0, o1); w.y = cvt_pk_bf16(o2, o3); w.z = cvt_pk_bf16(o4, o5); w.w = cvt_pk_bf16(o6, o7);
        Qh[0] = __builtin_bit_cast(bf16x8, w);
    }
}
__device__ __forceinline__ float red_g(float v) { return gsum4(v); }
__device__ __forceinline__ float sigmoidf_(float x) { return 1.0f / (1.0f + __expf(-x)); }

__device__ __forceinline__ void nsa_cmp_item(const Ctx& c, const Args& a, int nb, int grp) {
    unsigned char* ws = a.ws;
    const bf16* UNSA = (const bf16*)(ws + WS_UNSA);
    const float* ROPE = (const float*)(ws + WS_ROPE); float* TMP = (float*)(ws + WS_TMP);
    const int lane = c.lane, g = lane >> 4, r = lane & 15;
    const int t = 128 * nb + 16 * c.wid + r;
    const float NEG = -__builtin_inff();
    AX ax; ax.impw = (LAS float*)(c.lds + IMP_OFF) + c.wid * (16 * 128); ax.tc = 0.f; ax.linv[0] = ax.linv[1] = ax.linv[2] = 0.f; ax.first = true; ax.sel[0] = ax.sel[1] = ax.sel[2] = ax.sel[3] = 0u;
    const int nT = (8 * nb + 70) >> 6;
    const bf16* KCC = (const bf16*)(ws + WS_KCC) + (size_t)grp * 512 * 128; const bf16* VCC = (const bf16*)(ws + WS_VCC) + (size_t)grp * 512 * 128;
#pragma unroll 1
    for (int h = 0; h < 3; ++h) {
        const int head = 3 * grp + h;
        bf16x8 Q[1][4]; load_q(Q[0], UNSA + (size_t)t * NNSA + head * 128, ROPE + (size_t)t * 32, lane);
        f32x4 O[1][8]; float m[1], l[1];
        m[0] = NEG; l[0] = 0.f;
#pragma unroll
        for (int db = 0; db < 8; ++db) O[0][db] = (f32x4){0.f, 0.f, 0.f, 0.f};
        attn_run<1, 0>(c, KCC, 128, VCC, 128, 0, nT, Q, O, m, l, t, ax);
        { const float lt = red_g(l[0]); ax.linv[0] = lt > 0.f ? 1.0f / lt : 0.f; m[0] = (m[0] == NEG) ? 0.f : m[0]; }
        ax.tc = 0.f; ax.first = (h == 0);
        attn_run<1, 1>(c, KCC, 128, VCC, 128, 0, nT, Q, O, m, l, t, ax);
        const float gt = sigmoidf_(bf2f(UNSA[(size_t)t * NNSA + 2048 + 3 * head + 0]));
        float* tmpq = TMP + (size_t)t * QW + head * 128 + 4 * g;
#pragma unroll
        for (int db = 0; db < 8; ++db) *(f32x4*)(tmpq + 16 * db) = O[0][db] * gt;
    }
    {
        float v[32];
        int g_ = g; asm volatile("" : "+v"(g_));
        const LAS f32x4* src = (const LAS f32x4*)(ax.impw + r * 128 + 32 * g_);
#pragma unroll
        for (int k4 = 0; k4 < 8; ++k4) { const f32x4 w = src[k4]; v[4 * k4] = w.x; v[4 * k4 + 1] = w.y; v[4 * k4 + 2] = w.z; v[4 * k4 + 3] = w.w; }
        const int jt = t >> 6; const float PINF = __builtin_inff();
#pragma unroll
        for (int k = 0; k < 32; ++k) { const int j = 32 * g_ + k; v[k] = (j == 0 || j == jt || j == jt - 1) ? PINF : ((j > jt) ? NEG : v[k]); }
        unsigned selown = 0u;
#pragma unroll 1
        for (int round = 0; round < 16; ++round) {
            float bv = v[0]; int bk = 0;
#pragma unroll
            for (int k = 1; k < 32; ++k) { const bool gt = v[k] > bv; bv = gt ? v[k] : bv; bk = gt ? k : bk; }
            int bidx = 32 * g_ + bk;
#pragma unroll
            for (int o = 16; o <= 32; o <<= 1) { const float ov = __shfl_xor(bv, o); const int oi = __shfl_xor(bidx, o); const bool take = (ov > bv) || (ov == bv && oi < bidx); bv = take ? ov : bv; bidx = take ? oi : bidx; }
            const bool mine = (bidx >> 5) == g_; const int kk = bidx & 31;
            selown |= mine ? (1u << kk) : 0u;
#pragma unroll
            for (int k = 0; k < 32; ++k) v[k] = (mine && k == kk) ? NEG : v[k];
        }
        ((unsigned*)(ws + WS_SELB))[((size_t)t * 4 + grp) * 4 + g_] = selown;
    }
}

__device__ __forceinline__ void nsa_sw_item(const Ctx& c, const Args& a, int nb, int head) {
    unsigned char* ws = a.ws;
    const bf16* UNSA = (const bf16*)(ws + WS_UNSA); const bf16* UKV = (const bf16*)(ws + WS_UKV);
    const float* ROPE = (const float*)(ws + WS_ROPE); const float* TMP = (const float*)(ws + WS_TMP); bf16* CAT = (bf16*)(ws + WS_CAT);
    const int lane = c.lane, g = lane >> 4, r = lane & 15, grp = head / 3;
    const int t = 128 * nb + 16 * c.wid + r;
    const float NEG = -__builtin_inff();
    AX ax; ax.impw = nullptr; ax.tc = 0.f; ax.linv[0] = ax.linv[1] = ax.linv[2] = 0.f; ax.first = true;
    { const u32x4 sw = *(const u32x4*)((const unsigned*)(ws + WS_SELB) + ((size_t)t * 4 + grp) * 4); ax.sel[0] = sw.x; ax.sel[1] = sw.y; ax.sel[2] = sw.z; ax.sel[3] = sw.w; }
    bf16x8 Q[1][4]; load_q(Q[0], UNSA + (size_t)t * NNSA + head * 128, ROPE + (size_t)t * 32, lane);
    f32x4 O[1][8]; float m[1], l[1];
    m[0] = NEG; l[0] = 0.f;
#pragma unroll
    for (int db = 0; db < 8; ++db) O[0][db] = (f32x4){0.f, 0.f, 0.f, 0.f};
    attn_run<1, 2>(c, (const bf16*)(ws + WS_KSR) + (size_t)grp * S * 128, 128, UKV + 1536 + grp * 128, NKV, 0, 2 * nb + 2, Q, O, m, l, t, ax);
    f32x4 acc[8];
    { const float lt = red_g(l[0]); const float sc = (lt > 0.f ? 1.0f / lt : 0.f) * sigmoidf_(bf2f(UNSA[(size_t)t * NNSA + 2048 + 3 * head + 1]));
      const float* tmpq = TMP + (size_t)t * QW + head * 128 + 4 * g;
#pragma unroll
      for (int db = 0; db < 8; ++db) acc[db] = *(const f32x4*)(tmpq + 16 * db) + O[0][db] * sc; }
    m[0] = NEG; l[0] = 0.f;
#pragma unroll
    for (int db = 0; db < 8; ++db) O[0][db] = (f32x4){0.f, 0.f, 0.f, 0.f};
    attn_run<1, 3>(c, (const bf16*)(ws + WS_KWR) + (size_t)grp * S * 128, 128, UKV + 2560 + grp * 128, NKV, (2 * nb - 8) > 0 ? (2 * nb - 8) : 0, 2 * nb + 2, Q, O, m, l, t, ax);
    { const float lt = red_g(l[0]); const float sc = (lt > 0.f ? 1.0f / lt : 0.f) * sigmoidf_(bf2f(UNSA[(size_t)t * NNSA + 2048 + 3 * head + 2]));
      bf16* catq = CAT + (size_t)t * D + head * 128 + 4 * g;
#pragma unroll
      for (int db = 0; db < 8; ++db) { const f32x4 o = acc[db] + O[0][db] * sc; u32x2 w; w.x = cvt_pk_bf16(o.x, o.y); w.y = cvt_pk_bf16(o.z, o.w); *(u32x2*)(catq + 16 * db) = w; } }
}

struct AX2 { const LAS unsigned* selw; };
constexpr int SELW_OFF = 131072;
template <int MODE>
__device__ __forceinline__ void attn_run2(const Ctx& c, const bf16* Kg, int ldk, const bf16* Vg, int ldv, int tile_lo, int tile_hi,
                                          const bf16x8 (&Q)[2][4], f32x4 (&O)[2][8], float (&m)[2], float (&l)[2], int t0, const AX2& a2, AX& ax, int lane) {
    const int kh = c.wid >> 2, qs = c.wid & 3;
    const int q_lo = __builtin_amdgcn_readfirstlane(t0) & ~127;
    const int npairs = (tile_hi - tile_lo + 1) >> 1;
    __syncthreads();
    if (npairs > 0) { stage_kv(c.lds, Kg, ldk, Vg, ldv, 64 * tile_lo, c.wid, lane); if (tile_lo + 1 < tile_hi) stage_kv(c.lds + KV_BUF, Kg, ldk, Vg, ldv, 64 * (tile_lo + 1), c.wid, lane); }
    for (int pi = 0; pi < npairs; ++pi) {
        const int cur = pi & 1;
        asm volatile("s_waitcnt vmcnt(0)" ::: "memory");
        __syncthreads();
        if (pi + 1 < npairs) { const int Tn = tile_lo + 2 * (pi + 1);
            stage_kv(c.lds + (cur ^ 1) * 2 * KV_BUF, Kg, ldk, Vg, ldv, 64 * Tn, c.wid, lane);
            if (Tn + 1 < tile_hi) stage_kv(c.lds + (cur ^ 1) * 2 * KV_BUF + KV_BUF, Kg, ldk, Vg, ldv, 64 * (Tn + 1), c.wid, lane); }
        const int T = tile_lo + 2 * pi + kh;
        if (T < tile_hi) {
            unsigned csel = 3u; bool doit = true;
            if (MODE == 2) {
                const int w = T >> 5;
                const unsigned w0 = a2.selw[(lane & 15) * 4 + w], w1 = a2.selw[(16 + (lane & 15)) * 4 + w];
                csel = ((w0 >> (T & 31)) & 1u) | (((w1 >> (T & 31)) & 1u) << 1);
                doit = __ballot(csel != 0u) != 0ull;
            }
            bool em = false;
            if (MODE == 2) em = (64 * T + 63 > q_lo);
            if (MODE == 3) em = (64 * T + 63 > q_lo) || (64 * T <= q_lo + 127 - 512);
            LAS unsigned char* kb_ = c.lds + cur * 2 * KV_BUF + kh * KV_BUF;
            if (doit) {
                if (em) attn_tile<2, MODE, true, 16>(kb_, kb_ + 16384, Q, O, m, l, 64 * T, T, t0, lane, csel, ax);
                else attn_tile<2, MODE, false, 16>(kb_, kb_ + 16384, Q, O, m, l, 64 * T, T, t0, lane, csel, ax);
            }
        }
    }
    __syncthreads();
    LAS float* mb = (LAS float*)c.lds + qs * (68 * 64) + lane;
    if (kh == 1) {
#pragma unroll
        for (int b = 0; b < 2; ++b) { mb[(b * 34 + 0) * 64] = m[b]; mb[(b * 34 + 1) * 64] = l[b];
#pragma unroll
            for (int db = 0; db < 8; ++db) { mb[(b * 34 + 2 + 4 * db) * 64] = O[b][db].x; mb[(b * 34 + 3 + 4 * db) * 64] = O[b][db].y; mb[(b * 34 + 4 + 4 * db) * 64] = O[b][db].z; mb[(b * 34 + 5 + 4 * db) * 64] = O[b][db].w; } }
    }
    __syncthreads();
    if (kh == 0) {
        const float NEG = -__builtin_inff();
#pragma unroll
        for (int b = 0; b < 2; ++b) { const float mo = mb[(b * 34 + 0) * 64], lo_ = mb[(b * 34 + 1) * 64];
            const float mn = fmaxf(m[b], mo); const float mu = (mn == NEG) ? 0.f : mn; const float sa = fexp2(m[b] - mu), sb = fexp2(mo - mu);
            l[b] = l[b] * sa + lo_ * sb; m[b] = mn;
#pragma unroll
            for (int db = 0; db < 8; ++db) { f32x4 o; o.x = mb[(b * 34 + 2 + 4 * db) * 64]; o.y = mb[(b * 34 + 3 + 4 * db) * 64]; o.z = mb[(b * 34 + 4 + 4 * db) * 64]; o.w = mb[(b * 34 + 5 + 4 * db) * 64];
                O[b][db] = O[b][db] * sa + o * sb; } }
    }
}

__device__ __forceinline__ void nsa_sw_item2(const Ctx& c, const Args& a, int nb, int head) {
    unsigned char* ws = a.ws;
    const bf16* UNSA = (const bf16*)(ws + WS_UNSA); const bf16* UKV = (const bf16*)(ws + WS_UKV);
    const float* ROPE = (const float*)(ws + WS_ROPE); float* TMP = (float*)(ws + WS_TMP); bf16* CAT = (bf16*)(ws + WS_CAT);
    int lane = c.lane; asm volatile("" : "+v"(lane));
    const int g = lane >> 4, r = lane & 15, grp = head / 3, kh = c.wid >> 2, qs = c.wid & 3;
    const int t0 = 128 * nb + 32 * qs + r;
    const float NEG = -__builtin_inff();
    AX ax; ax.impw = nullptr; ax.tc = 0.f; ax.linv[0] = ax.linv[1] = ax.linv[2] = 0.f; ax.first = true; ax.sel[0] = ax.sel[1] = ax.sel[2] = ax.sel[3] = 0u;
    AX2 a2; a2.selw = (const LAS unsigned*)(c.lds + SELW_OFF) + (32 * qs) * 4;
    bf16x8 Q[2][4];
#pragma unroll
    for (int b = 0; b < 2; ++b) { const int tb = t0 + 16 * b;
        ((LAS unsigned*)(c.lds + SELW_OFF))[(32 * qs + 16 * b + r) * 4 + g] = ((const unsigned*)(ws + WS_SELB))[((size_t)tb * 4 + grp) * 4 + g];
        load_q(Q[b], UNSA + (size_t)tb * NNSA + head * 128, ROPE + (size_t)tb * 32, lane); }
    f32x4 O[2][8]; float m[2], l[2];
#pragma unroll
    for (int b = 0; b < 2; ++b) { m[b] = NEG; l[b] = 0.f;
#pragma unroll
        for (int db = 0; db < 8; ++db) O[b][db] = (f32x4){0.f, 0.f, 0.f, 0.f}; }
    attn_run2<2>(c, (const bf16*)(ws + WS_KSR) + (size_t)grp * S * 128, 128, UKV + 1536 + grp * 128, NKV, 0, 2 * nb + 2, Q, O, m, l, t0, a2, ax, lane);
    if (kh == 0) {
#pragma unroll
        for (int b = 0; b < 2; ++b) { const int tb = t0 + 16 * b; const float lt = red_g(l[b]); const float sc = (lt > 0.f ? 1.0f / lt : 0.f) * sigmoidf_(bf2f(UNSA[(size_t)tb * NNSA + 2048 + 3 * head + 1]));
            float* tmpq = TMP + (size_t)tb * QW + head * 128 + 4 * g;
#pragma unroll
            for (int db = 0; db < 8; ++db) { f32x4* p = (f32x4*)(tmpq + 16 * db); *p = *p + O[b][db] * sc; } }
    }
#pragma unroll
    for (int b = 0; b < 2; ++b) { m[b] = NEG; l[b] = 0.f;
#pragma unroll
        for (int db = 0; db < 8; ++db) O[b][db] = (f32x4){0.f, 0.f, 0.f, 0.f}; }
    attn_run2<3>(c, (const bf16*)(ws + WS_KWR) + (size_t)grp * S * 128, 128, UKV + 2560 + grp * 128, NKV, (2 * nb - 8) > 0 ? (2 * nb - 8) : 0, 2 * nb + 2, Q, O, m, l, t0, a2, ax, lane);
    if (kh == 0) {
#pragma unroll
        for (int b = 0; b < 2; ++b) { const int tb = t0 + 16 * b; const float lt = red_g(l[b]); const float sc = (lt > 0.f ? 1.0f / lt : 0.f) * sigmoidf_(bf2f(UNSA[(size_t)tb * NNSA + 2048 + 3 * head + 2]));
            const float* tmpq = TMP + (size_t)tb * QW + head * 128 + 4 * g; bf16* catq = CAT + (size_t)tb * D + head * 128 + 4 * g;
#pragma unroll
            for (int db = 0; db < 8; ++db) { const f32x4 o = *(const f32x4*)(tmpq + 16 * db) + O[b][db] * sc; u32x2 w; w.x = cvt_pk_bf16(o.x, o.y); w.y = cvt_pk_bf16(o.z, o.w); *(u32x2*)(catq + 16 * db) = w; } }
    }
}

__device__ __forceinline__ void mem_item(const Ctx& c, const Args& a, const bf16* qsrc, int ldq, int qcol, const bf16* memkv, int qb, int head) {
    const int lane = c.lane, g = lane >> 4, r = lane & 15;
    const int t = 128 * qb + 16 * c.wid + r;
    bf16x8 Q[1][4]; load_q(Q[0], qsrc + (size_t)t * ldq + qcol + head * 128, nullptr, lane);
    f32x4 O[1][8]; float m[1], l[1]; AX ax; ax.impw = nullptr; ax.first = true; ax.sel[0] = ax.sel[1] = ax.sel[2] = ax.sel[3] = 0u; ax.tc = 0.f; ax.linv[0] = ax.linv[1] = ax.linv[2] = 0.f;
    m[0] = -__builtin_inff(); l[0] = 0.f;
#pragma unroll
    for (int db = 0; db < 8; ++db) O[0][db] = (f32x4){0.f, 0.f, 0.f, 0.f};
    attn_run<1, 4>(c, memkv + head * 128, MEMKVW, memkv + 512 + head * 128, MEMKVW, 0, NMEM / 64, Q, O, m, l, t, ax);
    const float lt = red_g(l[0]); const float sc = lt > 0.f ? 1.0f / lt : 0.f;
    bf16* catq = (bf16*)(a.ws + WS_CAT) + (size_t)t * D + QW + head * 128 + 4 * g;
#pragma unroll
    for (int db = 0; db < 8; ++db) { const f32x4 o = O[0][db] * sc; u32x2 w; w.x = cvt_pk_bf16(o.x, o.y); w.y = cvt_pk_bf16(o.z, o.w); *(u32x2*)(catq + 16 * db) = w; }
}

__device__ __forceinline__ void unpack8(const u32x4 w, float (&f)[8]) { f[0] = bflo(w.x); f[1] = bfhi(w.x); f[2] = bflo(w.y); f[3] = bfhi(w.y); f[4] = bflo(w.z); f[5] = bfhi(w.z); f[6] = bflo(w.w); f[7] = bfhi(w.w); }
__device__ __forceinline__ u32x4 pack8(const float (&f)[8]) { u32x4 w; w.x = cvt_pk_bf16(f[0], f[1]); w.y = cvt_pk_bf16(f[2], f[3]); w.z = cvt_pk_bf16(f[4], f[5]); w.w = cvt_pk_bf16(f[6], f[7]); return w; }

__device__ __forceinline__ void conv_phase(const Ctx& c, const Args& a) {
    const bf16* U = (const bf16*)(a.ws + WS_UCONV); bf16* CAT = (bf16*)(a.ws + WS_CAT); const float* cw = (const float*)a.in[12];
    for (int idx = c.bid * NTHREADS + c.tid; idx < S * (CONVC / 8); idx += c.G * NTHREADS) {
        const int t = idx / (CONVC / 8), ch = (idx - t * (CONVC / 8)) * 8;
        float acc[8] = {0.f, 0.f, 0.f, 0.f, 0.f, 0.f, 0.f, 0.f};
#pragma unroll
        for (int k = 0; k < 3; ++k) { const int tt = t - 2 + k;
            if (tt >= 0) { float gc[8], hv[8]; unpack8(*(const u32x4*)(U + (size_t)tt * NCONV + CONVC + ch), gc); unpack8(*(const u32x4*)(U + (size_t)tt * NCONV + 2 * CONVC + ch), hv);
                const f32x4 w0 = *(const f32x4*)(cw + k * CONVC + ch), w1 = *(const f32x4*)(cw + k * CONVC + ch + 4);
                acc[0] += w0.x * (gc[0] * hv[0]); acc[1] += w0.y * (gc[1] * hv[1]); acc[2] += w0.z * (gc[2] * hv[2]); acc[3] += w0.w * (gc[3] * hv[3]);
                acc[4] += w1.x * (gc[4] * hv[4]); acc[5] += w1.y * (gc[5] * hv[5]); acc[6] += w1.z * (gc[6] * hv[6]); acc[7] += w1.w * (gc[7] * hv[7]); } }
        float gb[8]; unpack8(*(const u32x4*)(U + (size_t)t * NCONV + ch), gb);
#pragma unroll
        for (int j = 0; j < 8; ++j) acc[j] *= gb[j];
        *(u32x4*)(CAT + (size_t)t * D + ch) = pack8(acc);
    }
}

__device__ __forceinline__ void kvpost_phase(const Ctx& c, const Args& a) {
    const bf16* UKV = (const bf16*)(a.ws + WS_UKV); const float* ROPE = (const float*)(a.ws + WS_ROPE);
    for (int idx = c.bid * NTHREADS + c.tid; idx < S * 256; idx += c.G * NTHREADS) {
        const int t = idx >> 8, rem = idx & 255, which = rem >> 6, grp = (rem >> 4) & 3, ch = rem & 15;
        const int colbase = (which == 0) ? 0 : (which == 1) ? 512 : (which == 2) ? 1024 : 2048;
        const size_t dsto = (which == 0) ? WS_KCR : (which == 1) ? WS_VCR : (which == 2) ? WS_KSR : WS_KWR;
        const bf16* src = UKV + (size_t)t * NKV + colbase + grp * 128;
        bf16* dst = (bf16*)(a.ws + dsto) + ((size_t)grp * S + t) * 128;
        u32x4 own = *(const u32x4*)(src + 8 * ch);
        if (which != 1 && ch < 4) {
            const u32x4 par = *(const u32x4*)(src + 8 * (ch ^ 2));
            float xo[8], xp[8], o[8]; unpack8(own, xo); unpack8(par, xp);
            const float* rt = ROPE + (size_t)t * 32 + 8 * (ch & 1); const float sg = (ch < 2) ? -1.f : 1.f;
#pragma unroll
            for (int j = 0; j < 8; ++j) o[j] = xo[j] * rt[j] + sg * xp[j] * rt[16 + j];
            own = pack8(o);
        }
        *(u32x4*)(dst + 8 * ch) = own;
    }
}

__device__ __forceinline__ float gelu_tanh(float x) { const float y = 0.7978845608028654f * (x + 0.044715f * x * x * x); const float e = __expf(2.0f * y); const float th = 1.0f - 2.0f / (e + 1.0f); return 0.5f * x * (1.0f + th); }
__device__ __forceinline__ void compress_item(const Ctx& c, const bf16* src, const float* pos, const bf16* w1t, const bf16* w2t, bf16* dst, int rg) {
    const int lane = c.lane, g = lane >> 4, r = lane & 15, wid = c.wid;
    const int mrow = 16 * rg + r;
    const bf16* arow = src + (size_t)mrow * 2048;
    f32x4 acc[8];
#pragma unroll
    for (int nb = 0; nb < 8; ++nb) acc[nb] = (f32x4){0.f, 0.f, 0.f, 0.f};
#pragma unroll 2
    for (int ks = 0; ks < 16; ++ks) {
        const int k = 512 * wid + 32 * ks + 8 * g;
        float xa[8]; unpack8(*(const u32x4*)(arow + k), xa);
        const f32x4 p0 = *(const f32x4*)(pos + k), p1 = *(const f32x4*)(pos + k + 4);
        xa[0] += p0.x; xa[1] += p0.y; xa[2] += p0.z; xa[3] += p0.w; xa[4] += p1.x; xa[5] += p1.y; xa[6] += p1.z; xa[7] += p1.w;
        const bf16x8 xb = __builtin_bit_cast(bf16x8, pack8(xa));
#pragma unroll
        for (int nb = 0; nb < 8; ++nb) { const bf16x8 wf = *(const bf16x8*)(w1t + (size_t)(16 * nb + r) * 4096 + k); acc[nb] = __builtin_amdgcn_mfma_f32_16x16x32_bf16(wf, xb, acc[nb], 0, 0, 0); }
    }
    LAS f32x4* red = (LAS f32x4*)c.lds;
    __syncthreads();
#pragma unroll
    for (int nb = 0; nb < 8; ++nb) red[(wid * 8 + nb) * 64 + lane] = acc[nb];
    __syncthreads();
    if (wid == 0) {
        float hid[8][4];
#pragma unroll
        for (int nb = 0; nb < 8; ++nb) { f32x4 s = red[nb * 64 + lane];
#pragma unroll
            for (int w = 1; w < 8; ++w) s = s + red[(w * 8 + nb) * 64 + lane];
            hid[nb][0] = gelu_tanh(s.x); hid[nb][1] = gelu_tanh(s.y); hid[nb][2] = gelu_tanh(s.z); hid[nb][3] = gelu_tanh(s.w); }
        f32x4 o2[8];
#pragma unroll
        for (int ob = 0; ob < 8; ++ob) o2[ob] = (f32x4){0.f, 0.f, 0.f, 0.f};
#pragma unroll
        for (int cc = 0; cc < 4; ++cc) {
            u32x4 bw; bw.x = cvt_pk_bf16(hid[2 * cc][0], hid[2 * cc][1]); bw.y = cvt_pk_bf16(hid[2 * cc][2], hid[2 * cc][3]); bw.z = cvt_pk_bf16(hid[2 * cc + 1][0], hid[2 * cc + 1][1]); bw.w = cvt_pk_bf16(hid[2 * cc + 1][2], hid[2 * cc + 1][3]);
            const bf16x8 bfrag = __builtin_bit_cast(bf16x8, bw);
#pragma unroll
            for (int ob = 0; ob < 8; ++ob) { const bf16* wr_ = w2t + (size_t)(16 * ob + r) * 128 + 32 * cc + 4 * g;
                const u32x2 a0 = *(const u32x2*)wr_, a1 = *(const u32x2*)(wr_ + 16);
                u32x4 aw; aw.x = a0.x; aw.y = a0.y; aw.z = a1.x; aw.w = a1.y;
                o2[ob] = __builtin_amdgcn_mfma_f32_16x16x32_bf16(__builtin_bit_cast(bf16x8, aw), bfrag, o2[ob], 0, 0, 0); }
        }
#pragma unroll
        for (int ob = 0; ob < 8; ++ob) { u32x2 w; w.x = cvt_pk_bf16(o2[ob].x, o2[ob].y); w.y = cvt_pk_bf16(o2[ob].z, o2[ob].w); *(u32x2*)(dst + (size_t)mrow * 128 + 16 * ob + 4 * g) = w; }
    }
}

#define XB_TMO      128
#define XB_XCNT(j)  (256  + 64 * (j))
#define XB_XSUB(j)  (1280 + 64 * (j))
#define XB_XGEN(j)  (2304 + 64 * (j))
#define XB_TOP      3328
#define XB_TOPGEN   3392
#define XCD_BAR_WORDS 3456
#define XB_SPIN_CAP (1u << 18)

__device__ __forceinline__ unsigned xb_ld(unsigned* p)              { return __hip_atomic_load(p, __ATOMIC_RELAXED, __HIP_MEMORY_SCOPE_AGENT); }
__device__ __forceinline__ unsigned xb_add(unsigned* p, unsigned v) { return __hip_atomic_fetch_add(p, v, __ATOMIC_RELAXED, __HIP_MEMORY_SCOPE_AGENT); }
__device__ __forceinline__ unsigned xb_xcc_id() { return (unsigned)__builtin_amdgcn_s_getreg((3 << 11) | 20) & 0xFu; }
#define XB_SPIN(cond, bar) do { unsigned _sp = 0; while (cond) { __builtin_amdgcn_s_sleep(1); \
    if ((++_sp & 255u) == 0u) { if (xb_ld(&(bar)[XB_TMO])) break; if (_sp > XB_SPIN_CAP) { atomicAdd(&(bar)[XB_TMO], 1u); break; } } } } while (0)

struct XcdBarrier {
    unsigned* bar; unsigned x;
    volatile LAS unsigned* st;
};

__device__ __forceinline__ XcdBarrier xcd_barrier_post(unsigned* bar, volatile LAS unsigned* st) {
    XcdBarrier b; b.bar = bar; b.x = xb_xcc_id(); b.st = st;
    if (threadIdx.x == 0) (void)xb_add(&bar[XB_XCNT(b.x)], 1u);
    return b;
}
__device__ __forceinline__ void xcd_barrier_complete(unsigned* bar, unsigned x, unsigned& nloc, unsigned& nx) {
    const unsigned G = gridDim.x * gridDim.y * gridDim.z;
    unsigned sum, cnt, mine, sp = 0u;
    for (;;) {
        sum = 0u; cnt = 0u; mine = 0u;
#pragma unroll
        for (unsigned j = 0; j < 16; ++j) { const unsigned c = xb_ld(&bar[XB_XCNT(j)]); sum += c; cnt += (c > 0u) ? 1u : 0u; mine = (j == x) ? c : mine; }
        if (sum == G) break;
        __builtin_amdgcn_s_sleep(1);
        if ((++sp & 255u) == 0u) { if (xb_ld(&bar[XB_TMO])) break; if (sp > XB_SPIN_CAP) { atomicAdd(&bar[XB_TMO], 1u); break; } }
    }
    nloc = mine > 0u ? mine : 1u; nx = cnt > 0u ? cnt : 1u;
}

__device__ __forceinline__ void xcd_barrier(const XcdBarrier& b) {
    asm volatile("s_waitcnt vmcnt(0)" ::: "memory");
    __syncthreads();
    if (threadIdx.x == 0) {
        unsigned* bar = b.bar;
        __builtin_amdgcn_s_waitcnt(0);
        unsigned nloc = b.st[0], nx = b.st[1];
        if (nloc == 0u) { xcd_barrier_complete(bar, b.x, nloc, nx); b.st[0] = nloc; b.st[1] = nx; }
        const unsigned old = xb_add(&bar[XB_XSUB(b.x)], 1u);
        const unsigned gen = old / nloc;
        if (old + 1u == (gen + 1u) * nloc) {
            __builtin_amdgcn_fence(__ATOMIC_RELEASE, "agent");
            asm volatile("s_waitcnt vmcnt(0)" ::: "memory");
            const unsigned og = xb_add(&bar[XB_TOP], 1u);
            const unsigned tg = og / nx;
            if (og + 1u == (tg + 1u) * nx) xb_add(&bar[XB_TOPGEN], 1u);
            else XB_SPIN(xb_ld(&bar[XB_TOPGEN]) == tg, bar);
            __builtin_amdgcn_fence(__ATOMIC_ACQUIRE, "agent");
            xb_add(&bar[XB_XGEN(b.x)], 1u);
            asm volatile("s_waitcnt vmcnt(0)" ::: "memory");
        } else {
            XB_SPIN(xb_ld(&bar[XB_XGEN(b.x)]) == gen, bar);
            __builtin_amdgcn_fence(__ATOMIC_ACQUIRE, "agent");
            asm volatile("s_waitcnt vmcnt(0)" ::: "memory");
        }
    }
    __syncthreads();
}

constexpr int MISC_OFF = 131072 + 2048;
__device__ const unsigned short SW_OFF[257] = {0,2,4,6,8,10,12,14,16,18,20,22,24,26,28,30,32,34,36,38,40,42,44,46,48,50,52,54,56,58,60,62,64,66,68,70,72,74,76,78,80,82,84,86,88,90,92,94,96,98,100,102,104,106,108,110,112,114,116,118,120,122,124,126,128,130,132,134,136,138,140,142,144,146,148,150,152,154,156,158,160,162,164,166,168,170,172,174,176,178,180,182,184,186,188,190,192,194,196,198,200,202,204,206,208,210,212,214,216,218,220,222,224,226,228,230,232,234,236,238,240,242,244,246,248,250,252,254,256,258,260,262,264,266,268,270,272,274,276,278,280,282,284,286,288,290,292,294,296,298,300,302,304,306,308,310,312,316,320,324,328,333,338,343,348,353,358,363,368,372,376,380,384,389,394,399,404,409,414,419,424,428,432,436,440,445,450,455,460,465,470,475,480,484,488,492,496,501,506,511,516,521,526,531,536,540,544,548,552,557,562,567,572,577,582,587,592,596,600,604,608,613,618,623,628,633,638,643,648,652,656,660,664,669,674,679,684,689,694,699,704,708,712,716,720,724,728,732,736,740,744,748,752,756,760,764,768};
__device__ const unsigned short SW_TAB[768] = {0,300,1,301,2,302,3,303,4,304,5,305,6,306,7,307,8,308,9,309,10,310,11,311,12,288,13,289,14,290,15,291,16,292,17,293,18,294,19,295,20,296,21,297,22,298,23,299,24,276,25,277,26,278,27,279,28,280,29,281,30,282,31,283,32,284,33,285,34,286,35,287,36,264,37,265,38,266,39,267,40,268,41,269,42,270,43,271,44,272,45,273,46,274,47,275,48,252,49,253,50,254,51,255,52,256,53,257,54,258,55,259,56,260,57,261,58,262,59,263,60,240,61,241,62,242,63,243,64,244,65,245,66,246,67,247,68,248,69,249,70,250,71,251,72,228,73,229,74,230,75,231,76,232,77,233,78,234,79,235,80,236,81,237,82,238,83,239,84,216,85,217,86,218,87,219,88,220,89,221,90,222,91,223,92,224,93,225,94,226,95,227,96,204,97,205,98,206,99,207,100,208,101,209,102,210,103,211,104,212,105,213,106,214,107,215,108,192,109,193,110,194,111,195,112,196,113,197,114,198,115,199,116,200,117,201,118,202,119,203,120,180,121,181,122,182,123,183,124,184,125,185,126,186,127,187,128,188,129,189,130,190,131,191,132,168,133,169,134,170,135,171,136,172,137,173,138,174,139,175,140,176,141,177,142,178,143,179,144,156,145,157,146,158,147,159,148,160,149,161,150,162,151,163,152,164,153,165,154,166,155,167,312,500,524,640,313,501,525,641,314,502,526,642,315,503,527,643,316,512,600,708,712,317,513,601,709,713,318,514,602,710,714,319,515,603,711,715,320,516,604,696,716,321,517,605,697,717,322,518,606,698,718,323,519,607,699,719,324,488,528,644,325,489,529,645,326,490,530,646,327,491,531,647,328,492,576,700,720,329,493,577,701,721,330,494,578,702,722,331,495,579,703,723,332,496,580,704,724,333,497,581,705,725,334,498,582,706,726,335,499,583,707,727,336,476,532,624,337,477,533,625,338,478,534,626,339,479,535,627,340,480,584,684,728,341,481,585,685,729,342,482,586,686,730,343,483,587,687,731,344,484,588,688,732,345,485,589,689,733,346,486,590,690,734,347,487,591,691,735,348,464,536,628,349,465,537,629,350,466,538,630,351,467,539,631,352,468,592,692,736,353,469,593,693,737,354,470,594,694,738,355,471,595,695,739,356,472,596,672,740,357,473,597,673,741,358,474,598,674,742,359,475,599,675,743,360,452,540,632,361,453,541,633,362,454,542,634,363,455,543,635,364,456,544,676,744,365,457,545,677,745,366,458,546,678,746,367,459,547,679,747,368,460,548,680,748,369,461,549,681,749,370,462,550,682,750,371,463,551,683,751,372,440,568,612,373,441,569,613,374,442,570,614,375,443,571,615,376,444,552,660,752,377,445,553,661,753,378,446,554,662,754,379,447,555,663,755,380,448,556,664,756,381,449,557,665,757,382,450,558,666,758,383,451,559,667,759,384,428,572,616,385,429,573,617,386,430,574,618,387,431,575,619,388,432,560,668,760,389,433,561,669,761,390,434,562,670,762,391,435,563,671,763,392,436,564,648,764,393,437,565,649,765,394,438,566,650,766,395,439,567,651,767,396,416,608,620,397,417,609,621,398,418,610,622,399,419,611,623,400,420,504,652,401,421,505,653,402,422,506,654,403,423,507,655,404,424,508,656,405,425,509,657,406,426,510,658,407,427,511,659,408,412,520,636,409,413,521,637,410,414,522,638,411,415,523,639};
#ifndef REPEAT_MASK
#define REPEAT_MASK 0u
#endif
__device__ __forceinline__ bool refresh(Ctx& c, int rep) { if (rep) __syncthreads(); int tid = threadIdx.x; asm volatile("" : "+v"(tid)); c.tid = tid; c.lane = tid & 63; return true; }
__global__ void __launch_bounds__(NTHREADS) fwd_megakernel(Args a) {
    extern __shared__ __attribute__((aligned(16))) unsigned char lds_raw[];
    __builtin_assume(__builtin_amdgcn_workitem_id_y() == 0); __builtin_assume(__builtin_amdgcn_workitem_id_z() == 0);
    cg::grid_group grid = cg::this_grid();
    Ctx c; c.lds = (LAS unsigned char*)lds_raw; c.tid = threadIdx.x; c.lane = c.tid & 63; c.wid = __builtin_amdgcn_readfirstlane(c.tid >> 6); c.G = gridDim.x; c.bid = blockIdx.x;
    unsigned char* ws = a.ws;
    const float* x = (const float*)a.in[0];
    float* SS = (float*)(ws + WS_SS); const float* kv_norm = (const float*)a.in[14];
    float* H = (float*)(ws + WS_H); bf16* XN = (bf16*)(ws + WS_XN); bf16* XKV = (bf16*)(ws + WS_XKV); bf16* ACT = (bf16*)(ws + WS_ACT);
    bf16* UCONV = (bf16*)(ws + WS_UCONV); bf16* UNSA = (bf16*)(ws + WS_UNSA); bf16* UKV = (bf16*)(ws + WS_UKV); bf16* CAT = (bf16*)(ws + WS_CAT);
    const float* ffn_norm = (const float*)a.in[3]; const float* mix_norm = (const float*)a.in[7];
    const int lo = a.ph_lo, hi = a.ph_hi;
    volatile LAS unsigned* MISC = (volatile LAS unsigned*)(c.lds + MISC_OFF);
    if (c.tid < 2) MISC[c.tid] = 0u;
    __syncthreads();
    XcdBarrier bar; bar.bar = (unsigned*)(ws + WS_CTL); bar.x = 0; bar.st = MISC;
    if (hi - lo > 1) bar = xcd_barrier_post((unsigned*)(ws + WS_CTL), MISC);
    const int rc = c.G - 1 - c.bid;
#define PH(k) if (lo <= (k) && (k) < hi) for (int rep_ = 0; rep_ <= (int)((REPEAT_MASK >> (k)) & 1u); ++rep_) if (refresh(c, rep_))
#define SYNC(k) if (lo <= (k) && (k) + 1 < hi) { xcd_barrier(bar); }
#define WGU(f) ((const bf16*)(ws + WS_WGU + (size_t)(f) * SZ_WGU))
#define WD(f) ((const bf16*)(ws + WS_WD + (size_t)(f) * SZ_WD))
    if (hi < 0) grid.sync();
    PH(0) { prologue(c, a); } SYNC(0)
    PH(1) { run_gemm(c, XN, WGU(0), S, NGU, D, EpiSwiGLU{ACT, FF}, c.bid);
            run_gemm(c, (const bf16*)(ws + WS_MEMN), (const bf16*)(ws + WS_WMEM), NMEM, MEMKVW, D, EpiPlain{(bf16*)(ws + WS_MEMKV), MEMKVW}, rc);
            run_gemm(c, (const bf16*)(ws + WS_MEMN + (size_t)NMEM * D * 2), (const bf16*)(ws + WS_WMEM + (size_t)MEMKVW * D * 2), NMEM, MEMKVW, D, EpiPlain{(bf16*)(ws + WS_MEMKV + (size_t)NMEM * MEMKVW * 2), MEMKVW}, (rc + c.G - 4) % c.G);
            if (c.G == 256 && c.bid >= 128 && c.bid < 248) convert_segs(c, a, CV_P1, c.bid - 128, 120); } SYNC(1)
    PH(2) { run_gemm(c, ACT, WD(0), S, D, FF, EpiRes{x, H, D, 0.5f, SS, XN}, c.bid); } SYNC(2)
    PH(4) { run_gemm(c, XN, (const bf16*)(ws + WS_WCONV), S, NCONV, D, EpiPlain{UCONV, NCONV, SS}, c.bid);
            if (c.G == 256 && c.bid >= 128) convert_segs(c, a, CV_P4, c.bid - 128, 128); } SYNC(4)
    PH(5) { conv_phase(c, a);
            for (int it = c.bid; it < 256; it += c.G) mem_item(c, a, UCONV, NCONV, 3 * CONVC, (const bf16*)(ws + WS_MEMKV), it >> 2, it & 3); } SYNC(5)
    PH(6) { run_gemm(c, CAT, (const bf16*)(ws + WS_WOUT), S, D, D, EpiRes{H, H, D, 1.0f, SS + S, XN}, c.bid); } SYNC(6)
    PH(8) { run_gemm(c, XN, WGU(1), S, NGU, D, EpiSwiGLU{ACT, FF, SS + S}, c.bid);
            if (c.G == 256 && c.bid >= 128) convert_segs(c, a, CV_P8, c.bid - 128, 128); } SYNC(8)
    PH(9) { run_gemm(c, ACT, WD(1), S, D, FF, EpiRes{H, H, D, 0.5f, SS + 2 * S, XN}, c.bid); } SYNC(9)
    PH(11) { run_gemm(c, XN, WGU(2), S, NGU, D, EpiSwiGLU{ACT, FF, SS + 2 * S}, c.bid);
             run_gemm(c, XN, (const bf16*)(ws + WS_WKV), S, NKV, D, EpiPlain{UKV, NKV, SS + 2 * S}, rc); } SYNC(11)
    PH(12) { run_gemm(c, ACT, WD(2), S, D, FF, EpiRes{H, H, D, 0.5f, SS + 3 * S, XN}, c.bid); kvpost_phase(c, a); } SYNC(12)
    PH(14) { run_gemm(c, XN, (const bf16*)(ws + WS_WNSA), S, NNSA, D, EpiPlain{UNSA, NNSA, SS + 3 * S}, c.bid);
             const int nfree = (c.G > 64) ? c.G - 32 : c.G, b0 = (c.G > 64) ? c.bid - 32 : c.bid;
             for (int it = b0; it >= 0 && it < 256; it += nfree) { const int w = it >> 7;
                 compress_item(c, (const bf16*)(ws + (w ? WS_VCR : WS_KCR)), (const float*)a.in[w ? 19 : 16], (const bf16*)(ws + WS_W1C + (size_t)w * 128 * 4096 * 2),
                               (const bf16*)(ws + WS_W2C + (size_t)w * 128 * 128 * 2), (bf16*)(ws + (w ? WS_VCC : WS_KCC)), it & 127); }
             if (c.G == 256 && c.bid >= 32) { __syncthreads(); convert_segs(c, a, CV_P14, c.bid - 32, 224); } } SYNC(14)
    PH(15) { for (int it = c.bid; it < 256; it += c.G) nsa_cmp_item(c, a, 63 - (it >> 2), it & 3); } SYNC(15)
    PH(16) { const int vb = (c.bid & 7) * 32 + (c.bid >> 3);
             const int k0 = (c.G == 256) ? (int)SW_OFF[vb] : c.bid, k1 = (c.G == 256) ? (int)SW_OFF[vb + 1] : 768, kst = (c.G == 256) ? 1 : c.G;
             for (int k = k0; k < k1; k += kst) { const int i = (c.G == 256) ? (int)SW_TAB[k] : k;
                 nsa_sw_item2(c, a, 63 - i / 12, i % 12); }
             for (int it = c.bid; it < 256; it += c.G) mem_item(c, a, UNSA, NNSA, QW, (const bf16*)(ws + WS_MEMKV + (size_t)NMEM * MEMKVW * 2), it >> 2, it & 3); } SYNC(16)
    PH(17) { run_gemm(c, CAT, (const bf16*)(ws + WS_WOUT + (size_t)D * D * 2), S, D, D, EpiRes{H, H, D, 1.0f, SS + 4 * S, XN}, c.bid); } SYNC(17)
    PH(19) { run_gemm(c, XN, WGU(3), S, NGU, D, EpiSwiGLU{ACT, FF, SS + 4 * S}, c.bid);
             if (c.G == 256 && c.bid >= 128) convert_segs(c, a, CV_P19, c.bid - 128, 128); } SYNC(19)
    PH(20) { run_gemm(c, ACT, WD(3), S, D, FF, EpiRes{H, H, D, 0.5f}, c.bid); } SYNC(20)
    PH(21) { norm_rows(c, H, S, (const float*)a.in[22], nullptr, nullptr, nullptr, a.out); }
#undef PH
#undef SYNC
}

extern "C" void kernel_launch(void* const* d_in, const int* in_sizes, int n_in, void* d_out, int out_size, void* d_ws, size_t ws_size, hipStream_t stream) {
    static int grid = 0;
    if (grid == 0) {
        if (n_in != 23 || out_size != S * D || ws_size < WS_END) { fprintf(stderr, "kernel_launch: unexpected problem (n_in %d, out %d, ws %zu < %zu)\n", n_in, out_size, ws_size, (size_t)WS_END); grid = -1; return; }
        int dev = 0, cus = 0, per_cu = 0;
        hipGetDevice(&dev); hipDeviceGetAttribute(&cus, hipDeviceAttributeMultiprocessorCount, dev);
        if (hipFuncSetAttribute((const void*)fwd_megakernel, hipFuncAttributeMaxDynamicSharedMemorySize, LDS_BYTES) != hipSuccess) { fprintf(stderr, "kernel_launch: hipFuncSetAttribute failed\n"); grid = -1; return; }
        if (hipOccupancyMaxActiveBlocksPerMultiprocessor(&per_cu, (const void*)fwd_megakernel, NTHREADS, LDS_BYTES) != hipSuccess || per_cu < 1) { fprintf(stderr, "kernel_launch: occupancy query gave %d\n", per_cu); per_cu = 1; }
        (void)hipGetLastError();
        grid = cus * per_cu;
    }
    if (grid < 0) return;
    Args a{};
    for (int i = 0; i < 23; ++i) a.in[i] = d_in[i];
    a.out = (float*)d_out; a.ws = (unsigned char*)d_ws;
#if MULTI_LAUNCH
    for (int ph = 0; ph < NPHASES; ++ph) { a.ph_lo = ph; a.ph_hi = ph + 1; hipLaunchKernelGGL(fwd_megakernel, dim3(grid), dim3(NTHREADS), LDS_BYTES, stream, a); }
#else
    a.ph_lo = 0; a.ph_hi = NPHASES;
    if (hipMemsetAsync((unsigned char*)d_ws + WS_CTL, 0, CTL_BYTES, stream) != hipSuccess) { fprintf(stderr, "kernel_launch: memset of the barrier words failed\n"); return; }
    void* args[] = {&a};
    hipError_t e = hipLaunchCooperativeKernel((const void*)fwd_megakernel, dim3(grid), dim3(NTHREADS), args, LDS_BYTES, stream);
    if (e != hipSuccess) fprintf(stderr, "cooperative launch failed: %s (grid %d)\n", hipGetErrorString(e), grid);
#endif
}
```

```cpp
#include <hip/hip_runtime.h>
#include <hip/hip_cooperative_groups.h>
#include <cstdio>
#include <cstdint>
namespace cg = cooperative_groups;
namespace pg8 {
#define PG8_LAS __attribute__((address_space(3)))
typedef unsigned short bf16_t;
typedef short bf16x8 __attribute__((ext_vector_type(8)));
typedef float f32x4 __attribute__((ext_vector_type(4)));
typedef unsigned u32x4 __attribute__((ext_vector_type(4)));
constexpr int BM = 256, BK = 64, HALF = 128, HTB = HALF * BK * 2  , STAGE_BYTES = 8 * HTB, NXCD = 8, WGM = 8;

__host__ __device__ __forceinline__ int lds_byte(int r, int c) { const int st = (r >> 4) * 2 + (c >> 5), rr = r & 15, cc = c & 31, ob = rr * 64 + cc * 2; return st * 1024 + (ob ^ (((ob >> 9) & 1) << 5)); }
__host__ __device__ __forceinline__ void stage_rc(int b, int& R, int& C) { const int st = b / 1024, sb = b % 1024, swz = sb ^ (((sb >> 9) & 1) << 5); R = (st >> 1) * 16 + swz / 64; C = (st & 1) * 32 + (swz % 64) / 2; }
__host__ __device__ __forceinline__ int perm32(int rho) { const int n = rho >> 4, i = rho & 15; return 8 * (i >> 2) + 4 * n + (i & 3); }

struct Unit { int pm, pn; };
struct Gemm { const bf16_t* A; const bf16_t* Bt; int M, N, K; };

struct StaticOrder {
    int nM, nN, nwg, G, c;
    __host__ __device__ void init(int M, int N, int G_, int c_) { nM = M / BM; nN = N / BM; nwg = nM * nN; G = G_; c = c_; }
    __host__ __device__ bool next(int i, Unit& u) const {
        const long L = (long)i * G + c; if (L >= nwg) return false;
        int wgid = (int)L; { const int q = nwg / NXCD, r = nwg % NXCD, xcd = wgid % NXCD, off = wgid / NXCD; wgid = (xcd < r ? xcd * (q + 1) : r * (q + 1) + (xcd - r) * q) + off; }
        const int nig = WGM * nN, gid = wgid / nig, fm = gid * WGM, gsz = (nM - fm) < WGM ? (nM - fm) : WGM;
        u.pm = fm + ((wgid % nig) % gsz); u.pn = (wgid % nig) / gsz; return true;
    }
    __device__ __forceinline__ void a_ready(const Unit&) const {}
    __device__ __forceinline__ void done(const Unit&) const {}
};

__device__ __forceinline__ unsigned cvt_pk_bf16(float lo, float hi) { unsigned r; asm volatile("v_cvt_pk_bf16_f32 %0, %1, %2" : "=v"(r) : "v"(lo), "v"(hi)); return r; }
typedef float f32x2 __attribute__((ext_vector_type(2)));
template <class Epi, class Sched, bool ALIGN_EPI = false, bool SP2 = false>
__device__ __forceinline__ void gemm_phase(PG8_LAS unsigned char* lds, const Gemm g, const Sched& S, const Epi& E) {
    const int tid = threadIdx.x, wid = __builtin_amdgcn_readfirstlane(tid >> 6), lane = tid & 63, wr = wid >> 2, wc = wid & 3, fr = lane & 15, fq = lane >> 4;
    const int K = g.K, nt = K / BK;
    unsigned voffA[2], voffB[2];
#pragma unroll
    for (int i = 0; i < 2; ++i) { int R, C; stage_rc(tid * 16 + i * 8192, R, C); const int Rb = Epi::PERM ? ((R & ~31) + perm32(R & 31)) : R;
        voffA[i] = (unsigned)(R * K + C) * 2u; voffB[i] = (unsigned)(Rb * K + C) * 2u; }
    const size_t kstep = (size_t)(BK * 2);
    const size_t hstep = (size_t)HALF * K * 2;
    const size_t tstep = 2 * hstep;
    const unsigned ldsw = (unsigned)wid * 1024u;
    const int aoff = lds_byte(wr * 64 + fr, fq * 8), boff = lds_byte(wc * 32 + fr, fq * 8);
#define PG8_SA(b, h) (((b) * 2 + (h)) * HTB)
#define PG8_SB(b, h) ((4 + (b) * 2 + (h)) * HTB)
#define PG8_STAGE(bufoff, gbase, voff) do { _Pragma("unroll") for (int _i = 0; _i < 2; ++_i) \
        __builtin_amdgcn_global_load_lds((const unsigned*)((const char*)(gbase) + (voff)[_i]), (PG8_LAS unsigned*)(lds + (bufoff) + ldsw + _i * 8192), 16, 0, 0); } while (0)
#define PG8_LDA(dst, b, h) do { _Pragma("unroll") for (int m = 0; m < 4; ++m) _Pragma("unroll") for (int k = 0; k < 2; ++k) dst[m][k] = *(const PG8_LAS bf16x8*)(lds + PG8_SA(b, h) + aoff + m * 2048 + k * 1024); } while (0)
#define PG8_LDB(dst, b, h) do { _Pragma("unroll") for (int n = 0; n < 2; ++n) _Pragma("unroll") for (int k = 0; k < 2; ++k) dst[n][k] = *(const PG8_LAS bf16x8*)(lds + PG8_SB(b, h) + boff + n * 2048 + k * 1024); } while (0)
#define PG8_MMA(ai, bj, At, Bt) do { __builtin_amdgcn_s_setprio(1); _Pragma("unroll") for (int m = 0; m < 4; ++m) _Pragma("unroll") for (int n = 0; n < 2; ++n) _Pragma("unroll") for (int k = 0; k < 2; ++k) \
        acc[ai][bj][m][n] = __builtin_amdgcn_mfma_f32_16x16x32_bf16(Bt[n][k], At[m][k], acc[ai][bj][m][n], 0, 0, 0); __builtin_amdgcn_s_setprio(0); } while (0)
#define PG8_WAIT_V(n) asm volatile("s_waitcnt vmcnt(" #n ")" ::: "memory")
#define PG8_WAIT_L(n) asm volatile("s_waitcnt lgkmcnt(" #n ")" ::: "memory")
#define PG8_BAR __builtin_amdgcn_s_barrier()
#define PG8_SCHED __builtin_amdgcn_sched_barrier(0)
    Unit cur, nxt; int ui = 0;
    if (!S.next(0, cur)) return;
    f32x4 acc[2][2][4][2];
#pragma unroll
    for (int a = 0; a < 2; ++a)
#pragma unroll
        for (int b = 0; b < 2; ++b)
#pragma unroll
            for (int m = 0; m < 4; ++m)
#pragma unroll
                for (int n = 0; n < 2; ++n) acc[a][b][m][n] = (f32x4){0.f, 0.f, 0.f, 0.f};
    bf16x8 At[4][2], B0[2][2], B1[2][2];
    const char* cA = (const char*)g.A + (size_t)cur.pm * tstep; const char* cB = (const char*)g.Bt + (size_t)cur.pn * tstep;
    S.a_ready(cur);
    if constexpr (SP2) {
        PG8_STAGE(PG8_SB(0, 0), cB, voffB); PG8_STAGE(PG8_SB(0, 1), cB + hstep, voffB); PG8_STAGE(PG8_SA(0, 0), cA, voffA); PG8_STAGE(PG8_SA(0, 1), cA + hstep, voffA);
        if (wr == 1) PG8_BAR;
        PG8_WAIT_V(2); PG8_BAR;
        PG8_STAGE(PG8_SB(1, 0), cB + kstep, voffB); PG8_STAGE(PG8_SA(1, 0), cA + kstep, voffA); PG8_STAGE(PG8_SB(1, 1), cB + hstep + kstep, voffB);
        PG8_WAIT_V(6); PG8_BAR;
    } else {
        PG8_STAGE(PG8_SB(0, 0), cB, voffB); PG8_STAGE(PG8_SA(0, 0), cA, voffA); PG8_STAGE(PG8_SB(0, 1), cB + hstep, voffB); PG8_STAGE(PG8_SA(0, 1), cA + hstep, voffA);
        if (wr == 1) PG8_BAR;
        PG8_WAIT_V(4); PG8_BAR;
        PG8_STAGE(PG8_SB(1, 0), cB + kstep, voffB); PG8_STAGE(PG8_SA(1, 0), cA + kstep, voffA); PG8_STAGE(PG8_SB(1, 1), cB + hstep + kstep, voffB);
        PG8_WAIT_V(6); PG8_BAR;
    }
    for (;;) {
        const bool has_next = S.next(ui + 1, nxt);
        const char* nA = has_next ? (const char*)g.A + (size_t)nxt.pm * tstep : cA; const char* nB = has_next ? (const char*)g.Bt + (size_t)nxt.pn * tstep : cB;
        for (int t = 0; t < nt; t += 2) {
            const bool last = (t == nt - 2);
            const char* a1 = cA + (size_t)(t + 1) * kstep;
            const char* a2 = last ? nA : cA + (size_t)(t + 2) * kstep; const char* b2 = last ? nB : cB + (size_t)(t + 2) * kstep;
            const char* a3 = a2 + kstep; const char* b3 = b2 + kstep;
            if (last && has_next) S.a_ready(nxt);
            if constexpr (SP2) {
            PG8_LDB(B0, 0, 0); PG8_LDB(B1, 0, 1); PG8_SCHED; PG8_LDA(At, 0, 0); PG8_STAGE(PG8_SA(1, 1), a1 + hstep, voffA);
            PG8_WAIT_V(8); PG8_WAIT_L(0); PG8_BAR; PG8_MMA(0, 0, At, B0); PG8_MMA(0, 1, At, B1); PG8_BAR; PG8_SCHED;
            PG8_LDA(At, 0, 1); PG8_STAGE(PG8_SB(0, 0), b2, voffB); PG8_STAGE(PG8_SB(0, 1), b2 + hstep, voffB); PG8_STAGE(PG8_SA(0, 0), a2, voffA);
            PG8_WAIT_V(8); PG8_WAIT_L(0); PG8_BAR; PG8_MMA(1, 0, At, B0); PG8_MMA(1, 1, At, B1); PG8_BAR; PG8_SCHED;
            PG8_LDB(B0, 1, 0); PG8_LDB(B1, 1, 1); PG8_SCHED; PG8_LDA(At, 1, 0); PG8_STAGE(PG8_SA(0, 1), a2 + hstep, voffA);
            PG8_WAIT_V(8); PG8_WAIT_L(0); PG8_BAR; PG8_MMA(0, 0, At, B0); PG8_MMA(0, 1, At, B1); PG8_BAR; PG8_SCHED;
            PG8_LDA(At, 1, 1); PG8_STAGE(PG8_SB(1, 0), b3, voffB); PG8_STAGE(PG8_SB(1, 1), b3 + hstep, voffB); PG8_STAGE(PG8_SA(1, 0), a3, voffA);
            PG8_WAIT_V(8); PG8_WAIT_L(0); PG8_BAR; PG8_MMA(1, 0, At, B0); PG8_MMA(1, 1, At, B1); PG8_BAR; PG8_SCHED;
            } else {
            PG8_LDB(B0, 0, 0); PG8_SCHED; PG8_LDA(At, 0, 0); PG8_STAGE(PG8_SA(1, 1), a1 + hstep, voffA);
            PG8_WAIT_L(8); PG8_BAR; PG8_WAIT_L(0); PG8_MMA(0, 0, At, B0); PG8_BAR; PG8_SCHED;
            PG8_LDB(B1, 0, 1); PG8_STAGE(PG8_SB(0, 0), b2, voffB);
            PG8_BAR; PG8_WAIT_L(0); PG8_MMA(0, 1, At, B1); PG8_BAR;
            PG8_LDA(At, 0, 1); PG8_STAGE(PG8_SA(0, 0), a2, voffA);
            PG8_BAR; PG8_WAIT_L(0); PG8_MMA(1, 0, At, B0); PG8_BAR; PG8_SCHED;
            PG8_STAGE(PG8_SB(0, 1), b2 + hstep, voffB);
            PG8_WAIT_V(6); PG8_BAR; PG8_MMA(1, 1, At, B1); PG8_BAR;
            PG8_LDB(B0, 1, 0); PG8_SCHED; PG8_LDA(At, 1, 0); PG8_STAGE(PG8_SA(0, 1), a2 + hstep, voffA);
            PG8_WAIT_L(8); PG8_BAR; PG8_WAIT_L(0); PG8_MMA(0, 0, At, B0); PG8_BAR; PG8_SCHED;
            PG8_LDB(B1, 1, 1); PG8_STAGE(PG8_SB(1, 0), b3, voffB);
            PG8_BAR; PG8_WAIT_L(0); PG8_MMA(0, 1, At, B1); PG8_BAR;
            PG8_LDA(At, 1, 1); PG8_STAGE(PG8_SA(1, 0), a3, voffA);
            PG8_BAR; PG8_WAIT_L(0); PG8_MMA(1, 0, At, B0); PG8_BAR; PG8_SCHED;
            PG8_STAGE(PG8_SB(1, 1), b3 + hstep, voffB);
            PG8_WAIT_V(6); PG8_BAR; PG8_MMA(1, 1, At, B1); PG8_BAR;
            }
        }
        if constexpr (ALIGN_EPI) { if (wr == 0) PG8_BAR; }
        if constexpr (!Epi::AFTER_DRAIN) { E(acc, cur, wr, wc, fr, fq); S.done(cur); }
        if (!has_next) break;
#pragma unroll
        for (int a = 0; a < 2; ++a)
#pragma unroll
            for (int b = 0; b < 2; ++b)
#pragma unroll
                for (int m = 0; m < 4; ++m)
#pragma unroll
                    for (int n = 0; n < 2; ++n) acc[a][b][m][n] = (f32x4){0.f, 0.f, 0.f, 0.f};
        cur = nxt; cA = nA; cB = nB; ++ui;
        if constexpr (ALIGN_EPI) { if (wr == 1) PG8_BAR; }
    }
    PG8_WAIT_V(0);
    if constexpr (!ALIGN_EPI) { if (wr == 0) PG8_BAR; }
    PG8_BAR;
    if constexpr (Epi::AFTER_DRAIN) { E.fused(acc, cur, wr, wc, fr, fq, lds, wid, lane); S.done(cur); }
#undef PG8_SA
#undef PG8_SB
#undef PG8_STAGE
#undef PG8_LDA
#undef PG8_LDB
#undef PG8_MMA
#undef PG8_WAIT_V
#undef PG8_WAIT_L
#undef PG8_BAR
#undef PG8_SCHED
}
}

#define LAS __attribute__((address_space(3)))
typedef unsigned short bf16;
typedef short bf16x8 __attribute__((ext_vector_type(8)));
typedef short s16x4 __attribute__((ext_vector_type(4)));
typedef float f32x4 __attribute__((ext_vector_type(4)));
typedef unsigned u32x4 __attribute__((ext_vector_type(4)));
typedef unsigned u32x2 __attribute__((ext_vector_type(2)));
using pg8::cvt_pk_bf16;

#ifndef MULTI_LAUNCH
#define MULTI_LAUNCH 0
#endif

constexpr int S = 8192, D = 2048, FF = 5632, NGU = 2 * FF, NCONV = 5120, NNSA = 2304, NNSA_SRC = 2084, NKV = 3072, CONVC = 1536;
constexpr int NMEM = 256, MEMKVW = 1024, QW = 1536;
constexpr int NTHREADS = 512, NWAVES = 8, LDS_BYTES = 131072 + 2048 + 256;
constexpr int NPHASES = 22;

constexpr size_t al256(size_t x) { return (x + 255) & ~(size_t)255; }
constexpr size_t SZ_WGU = (size_t)NGU * D * 2, SZ_WD = (size_t)D * FF * 2;
constexpr size_t WS_WGU = 0;
constexpr size_t WS_WD = WS_WGU + 4 * SZ_WGU;
constexpr size_t WS_WCONV = WS_WD + 4 * SZ_WD;
constexpr size_t WS_WNSA = WS_WCONV + (size_t)NCONV * D * 2;
constexpr size_t WS_WOUT = WS_WNSA + (size_t)NNSA * D * 2;
constexpr size_t WS_WKV = WS_WOUT + 2 * (size_t)D * D * 2;
constexpr size_t WS_WMEM = WS_WKV + (size_t)NKV * D * 2;
constexpr size_t WS_W1C = WS_WMEM + 2 * (size_t)MEMKVW * D * 2;
constexpr size_t WS_W2C = WS_W1C + 2 * (size_t)128 * 4096 * 2;
constexpr size_t WS_H = WS_W2C + 2 * (size_t)128 * 128 * 2;
constexpr size_t WS_XN = WS_H + (size_t)S * D * 4;
constexpr size_t WS_XKV = WS_XN + (size_t)S * D * 2;
constexpr size_t WS_ACT = WS_XKV + (size_t)S * D * 2;
constexpr size_t WS_UCONV = WS_ACT;
constexpr size_t WS_UNSA = WS_ACT;
constexpr size_t WS_TMP = WS_ACT + (size_t)S * NNSA * 2;
constexpr size_t WS_UKV = WS_ACT + (size_t)S * FF * 2;
constexpr size_t WS_CAT = WS_UKV + (size_t)S * NKV * 2;
constexpr size_t WS_KCR = WS_CAT + (size_t)S * D * 2;
constexpr size_t SZ_KR = (size_t)4 * S * 128 * 2, SLACK = 16 * 128 * 2;
constexpr size_t WS_VCR = WS_KCR + SZ_KR + SLACK;
constexpr size_t WS_KSR = WS_VCR + SZ_KR + SLACK;
constexpr size_t WS_KWR = WS_KSR + SZ_KR;
constexpr size_t WS_KCC = WS_KWR + SZ_KR;
constexpr size_t WS_VCC = WS_KCC + (size_t)4 * 512 * 128 * 2;
constexpr size_t WS_MEMN = WS_VCC + (size_t)4 * 512 * 128 * 2;
constexpr size_t WS_MEMKV = WS_MEMN + 2 * (size_t)NMEM * D * 2;
constexpr size_t WS_ROPE = WS_MEMKV + 2 * (size_t)NMEM * MEMKVW * 2;
constexpr size_t WS_SELB = WS_ROPE + (size_t)S * 32 * 4;
constexpr size_t WS_SS = WS_SELB + (size_t)S * 4 * 4 * 4;
constexpr size_t WS_CTL = WS_SS + (size_t)5 * S * 4;
constexpr size_t CTL_BYTES = 16384;
constexpr size_t WS_END = WS_CTL + CTL_BYTES;
static_assert((size_t)S * NNSA * 2 + (size_t)S * QW * 4 <= (size_t)S * FF * 2, "overlay fits in ACT");
static_assert((size_t)S * NCONV * 2 <= (size_t)S * FF * 2, "overlay fits in ACT");
static_assert(WS_END <= (size_t)4 * 2 * 2 * 2048 * 5632 * 4, "workspace must fit the guaranteed size");

struct Args { const void* in[23]; float* out; unsigned char* ws; int ph_lo, ph_hi; };

struct Ctx { LAS unsigned char* lds; int tid, lane, wid, G, bid; };

__device__ __forceinline__ float bf2f(unsigned short b) { return __uint_as_float(((unsigned)b) << 16); }
__device__ __forceinline__ float bflo(unsigned w) { return __uint_as_float(w << 16); }
__device__ __forceinline__ float bfhi(unsigned w) { return __uint_as_float(w & 0xffff0000u); }
__device__ __forceinline__ float wave_sum(float v) {
#pragma unroll
    for (int o = 1; o < 64; o <<= 1) v += __shfl_xor(v, o);
    return v;
}
__device__ __forceinline__ float fexp2(float x) { return __builtin_amdgcn_exp2f(x); }

__device__ __forceinline__ float rstd_of(const float* ss, int row) { return ss ? 1.0f / sqrtf(ss[row] * (1.0f / D) + 1e-6f) : 1.0f; }
struct EpiPlain {
    static constexpr bool PERM = true, AFTER_DRAIN = false;
    bf16* O; int ldc; const float* ss = nullptr;
    __device__ __forceinline__ void operator()(const f32x4 (&acc)[2][2][4][2], const pg8::Unit& u, int wr, int wc, int fr, int fq) const {
        const int row0 = u.pm * 256 + wr * 64 + fr, col0 = u.pn * 256 + wc * 32 + 8 * fq;
#pragma unroll
        for (int ai = 0; ai < 2; ++ai)
#pragma unroll
            for (int m = 0; m < 4; ++m) { const int row = row0 + ai * 128 + m * 16; bf16* rowp = O + (size_t)row * ldc + col0; const float rs = rstd_of(ss, row);
#pragma unroll
                for (int bj = 0; bj < 2; ++bj) { const f32x4 v0 = acc[ai][bj][m][0] * rs, v1 = acc[ai][bj][m][1] * rs;
                    u32x4 w; w.x = cvt_pk_bf16(v0[0], v0[1]); w.y = cvt_pk_bf16(v0[2], v0[3]); w.z = cvt_pk_bf16(v1[0], v1[1]); w.w = cvt_pk_bf16(v1[2], v1[3]);
                    *(u32x4*)(rowp + bj * 128) = w; } }
    }
};
__device__ __forceinline__ float silu_mul(float g, float u) { return g * __builtin_amdgcn_rcpf(1.0f + fexp2(-1.4426950408889634f * g)) * u; }
struct EpiSwiGLU {
    static constexpr bool PERM = true, AFTER_DRAIN = false;
    bf16* O; int ldc; const float* ss = nullptr;
    __device__ __forceinline__ void operator()(const f32x4 (&acc)[2][2][4][2], const pg8::Unit& u, int wr, int wc, int fr, int fq) const {
        const int row0 = u.pm * 256 + wr * 64 + fr, col0 = u.pn * 128 + wc * 32 + 8 * fq;
#pragma unroll
        for (int ai = 0; ai < 2; ++ai)
#pragma unroll
            for (int m = 0; m < 4; ++m) { const int row = row0 + ai * 128 + m * 16; bf16* rowp = O + (size_t)row * ldc + col0; const float rs = rstd_of(ss, row);
                const f32x4 g0 = acc[ai][0][m][0] * rs, g1 = acc[ai][0][m][1] * rs, u0 = acc[ai][1][m][0] * rs, u1 = acc[ai][1][m][1] * rs;
                u32x4 w;
                w.x = cvt_pk_bf16(silu_mul(g0[0], u0[0]), silu_mul(g0[1], u0[1])); w.y = cvt_pk_bf16(silu_mul(g0[2], u0[2]), silu_mul(g0[3], u0[3]));
                w.z = cvt_pk_bf16(silu_mul(g1[0], u1[0]), silu_mul(g1[1], u1[1])); w.w = cvt_pk_bf16(silu_mul(g1[2], u1[2]), silu_mul(g1[3], u1[3]));
                *(u32x4*)rowp = w; }
    }
};
struct EpiRes {
    static constexpr bool PERM = true, AFTER_DRAIN = false;
    const float* base; float* out; int ldc; float alpha;
    float* ss = nullptr; bf16* o1 = nullptr;
    __device__ __forceinline__ void operator()(const f32x4 (&acc)[2][2][4][2], const pg8::Unit& u, int wr, int wc, int fr, int fq) const {
        const int row0 = u.pm * 256 + wr * 64 + fr, col0 = u.pn * 256 + wc * 32 + 8 * fq;
#pragma unroll
        for (int ai = 0; ai < 2; ++ai)
#pragma unroll
            for (int m = 0; m < 4; ++m) { const int row = row0 + ai * 128 + m * 16; const size_t off = (size_t)row * ldc + col0; float sq = 0.f;
#pragma unroll
                for (int bj = 0; bj < 2; ++bj) { const int co = bj * 128;
                    const f32x4 b0 = *(const f32x4*)(base + off + co), b1 = *(const f32x4*)(base + off + co + 4);
                    const f32x4 v0 = b0 + alpha * acc[ai][bj][m][0], v1 = b1 + alpha * acc[ai][bj][m][1];
                    *(f32x4*)(out + off + co) = v0; *(f32x4*)(out + off + co + 4) = v1;
                    if (ss) { sq += ((v0.x * v0.x + v0.y * v0.y) + (v0.z * v0.z + v0.w * v0.w)) + ((v1.x * v1.x + v1.y * v1.y) + (v1.z * v1.z + v1.w * v1.w));
                        u32x4 w; w.x = cvt_pk_bf16(v0.x, v0.y); w.y = cvt_pk_bf16(v0.z, v0.w); w.z = cvt_pk_bf16(v1.x, v1.y); w.w = cvt_pk_bf16(v1.z, v1.w); *(u32x4*)(o1 + off + co) = w; } }
                if (ss) { sq += __shfl_xor(sq, 16); sq += __shfl_xor(sq, 32); if (fq == 0) atomicAdd(ss + row, sq); } }
    }
};

template <class Epi>
__device__ __forceinline__ void run_gemm(const Ctx& c, const bf16* A, const bf16* Bt, int M, int N, int K, const Epi& E, int cidx) {
    pg8::Gemm g{A, Bt, M, N, K}; pg8::StaticOrder So; So.init(M, N, c.G, cidx);
    pg8::gemm_phase<Epi, pg8::StaticOrder, true, true>(c.lds, g, So, E);
}

struct Seg { const float* src; bf16* dst; int K, N, c0, nc, d0, mode; const float* gk; };
constexpr int NSEG = 25;
__device__ __forceinline__ Seg get_seg(const Args& a, int id) {
    Seg s; unsigned char* ws = a.ws; s.c0 = 0; s.d0 = 0; s.mode = 0; s.gk = nullptr;
    if (id < 12) { const int f = id / 3, kind = id - 3 * f;
        if (kind == 0) { s.src = (const float*)a.in[4] + (size_t)f * D * FF; s.dst = (bf16*)(ws + WS_WGU + f * SZ_WGU); s.K = D; s.N = FF; s.nc = FF; s.mode = 1; if (f > 0) s.gk = (const float*)a.in[3] + (size_t)f * D; }
        else if (kind == 1) { s.src = (const float*)a.in[5] + (size_t)f * D * FF; s.dst = (bf16*)(ws + WS_WGU + f * SZ_WGU); s.K = D; s.N = FF; s.nc = FF; s.mode = 1; s.d0 = 128; if (f > 0) s.gk = (const float*)a.in[3] + (size_t)f * D; }
        else { s.src = (const float*)a.in[6] + (size_t)f * FF * D; s.dst = (bf16*)(ws + WS_WD + f * SZ_WD); s.K = FF; s.N = D; s.nc = D; }
    } else if (id == 12) { s.src = (const float*)a.in[11]; s.dst = (bf16*)(ws + WS_WCONV); s.K = D; s.N = NCONV; s.nc = NCONV; s.gk = (const float*)a.in[7]; }
    else if (id == 13) { s.src = (const float*)a.in[13]; s.dst = (bf16*)(ws + WS_WNSA); s.K = D; s.N = NNSA_SRC; s.c0 = 0; s.nc = 1536; s.d0 = 0; s.gk = (const float*)a.in[7] + D; }
    else if (id == 14) { s.src = (const float*)a.in[13]; s.dst = (bf16*)(ws + WS_WNSA); s.K = D; s.N = NNSA_SRC; s.c0 = 1536; s.nc = 36; s.d0 = 2048; s.gk = (const float*)a.in[7] + D; }
    else if (id == 15) { s.src = (const float*)a.in[13]; s.dst = (bf16*)(ws + WS_WNSA); s.K = D; s.N = NNSA_SRC; s.c0 = 1572; s.nc = 512; s.d0 = 1536; s.gk = (const float*)a.in[7] + D; }
    else if (id <= 17) { const int l = id - 16; s.src = (const float*)a.in[10] + (size_t)l * D * D; s.dst = (bf16*)(ws + WS_WOUT + (size_t)l * D * D * 2); s.K = D; s.N = D; s.nc = D; }
    else if (id == 18) { s.src = (const float*)a.in[15]; s.dst = (bf16*)(ws + WS_WKV); s.K = D; s.N = NKV; s.nc = NKV; s.gk = (const float*)a.in[14]; }
    else if (id <= 20) { const int l = id - 19; s.src = (const float*)a.in[9] + (size_t)l * D * MEMKVW; s.dst = (bf16*)(ws + WS_WMEM + (size_t)l * MEMKVW * D * 2); s.K = D; s.N = MEMKVW; s.nc = MEMKVW; }
    else if (id <= 22) { const int w = id - 21; s.src = (const float*)a.in[w ? 20 : 17]; s.dst = (bf16*)(ws + WS_W1C + (size_t)w * 128 * 4096 * 2); s.K = 4096; s.N = 128; s.nc = 128; }
    else { const int w = id - 23; s.src = (const float*)a.in[w ? 21 : 18]; s.dst = (bf16*)(ws + WS_W2C + (size_t)w * 128 * 128 * 2); s.K = 128; s.N = 128; s.nc = 128; }
    return s;
}
__device__ __forceinline__ void transpose_item(const Seg& s, LAS float* scr, int item, int lane) {
    const int nblk = (s.nc + 31) >> 5, kb = item / nblk, nb = item - kb * nblk, k0 = 64 * kb, cb = 32 * nb;
    const int cl = cb + (lane & 31); const bool cok = cl < s.nc;
    const float* sp = s.src + (size_t)(k0 + (lane >> 5)) * s.N + s.c0 + cl;
    float tv[32];
#pragma unroll
    for (int i = 0; i < 32; ++i) tv[i] = cok ? __builtin_nontemporal_load(sp + (size_t)(2 * i) * s.N) : 0.f;
    if (s.gk) {
#pragma unroll
        for (int i = 0; i < 32; ++i) tv[i] *= s.gk[k0 + 2 * i + (lane >> 5)];
    }
#pragma unroll
    for (int i = 0; i < 32; ++i) scr[(2 * i + (lane >> 5)) * 33 + (lane & 31)] = tv[i];
    asm volatile("s_waitcnt lgkmcnt(0)" ::: "memory");
    const int c8 = lane & 7;
#pragma unroll
    for (int j = 0; j < 4; ++j) { const int n = (lane >> 3) + 8 * j; const int c = cb + n; const LAS float* q = scr + (8 * c8) * 33 + n;
        u32x4 o; o.x = cvt_pk_bf16(q[0 * 33], q[1 * 33]); o.y = cvt_pk_bf16(q[2 * 33], q[3 * 33]); o.z = cvt_pk_bf16(q[4 * 33], q[5 * 33]); o.w = cvt_pk_bf16(q[6 * 33], q[7 * 33]);
        const int drow = s.d0 + (s.mode ? ((c >> 7) * 256 + (c & 127)) : c);
        if (c < s.nc) *(u32x4*)(s.dst + (size_t)drow * s.K + k0 + 8 * c8) = o; }
    asm volatile("s_waitcnt lgkmcnt(0)" ::: "memory");
}

__device__ __forceinline__ void rms_row(const float* xrow, const float* g1, bf16* o1, const float* g2, bf16* o2, float* of, int lane) {
    const f32x4* xr = (const f32x4*)xrow + lane;
    f32x4 v[8]; float s = 0.f;
#pragma unroll
    for (int j = 0; j < 8; ++j) { v[j] = xr[64 * j]; s += (v[j].x * v[j].x + v[j].y * v[j].y) + (v[j].z * v[j].z + v[j].w * v[j].w); }
    const float rstd = 1.0f / sqrtf(wave_sum(s) * (1.0f / D) + 1e-6f);
#pragma unroll
    for (int j = 0; j < 8; ++j) { const f32x4 y = v[j] * rstd; const f32x4 ga = ((const f32x4*)g1)[lane + 64 * j]; const f32x4 a = y * ga;
        if (o1) { u32x2 w; w.x = cvt_pk_bf16(a.x, a.y); w.y = cvt_pk_bf16(a.z, a.w); ((u32x2*)o1)[lane + 64 * j] = w; }
        if (of) ((f32x4*)of)[lane + 64 * j] = a;
        if (o2) { const f32x4 gb = ((const f32x4*)g2)[lane + 64 * j]; const f32x4 b = y * gb; u32x2 w; w.x = cvt_pk_bf16(b.x, b.y); w.y = cvt_pk_bf16(b.z, b.w); ((u32x2*)o2)[lane + 64 * j] = w; } }
}
__device__ __forceinline__ void norm_rows(const Ctx& c, const float* src, int nrows, const float* g1, bf16* o1, const float* g2, bf16* o2, float* of) {
    const int gw = c.bid * NWAVES + c.wid, NGW = c.G * NWAVES;
    for (int r = gw; r < nrows; r += NGW) rms_row(src + (size_t)r * D, g1, o1 ? o1 + (size_t)r * D : nullptr, g2, o2 ? o2 + (size_t)r * D : nullptr, of ? of + (size_t)r * D : nullptr, c.lane);
}

__device__ __forceinline__ void convert_segs(const Ctx& c, const Args& a, unsigned mask, int widx, int nwork) {
    LAS float* scr = (LAS float*)(c.lds + c.wid * 16384);
    const int gw = widx * NWAVES + c.wid, NGW = nwork * NWAVES;
    int base = 0;
    for (int sid = 0; sid < NSEG; ++sid) {
        if (!((mask >> sid) & 1u)) continue;
        const Seg s = get_seg(a, sid);
        const int n = (s.K >> 6) * ((s.nc + 31) >> 5);
        int first = (gw - base) % NGW; if (first < 0) first += NGW;
        for (int it = first; it < n; it += NGW) transpose_item(s, scr, it, c.lane);
        base = (base + n) % NGW;
    }
}
constexpr unsigned SEGM(int i) { return 1u << i; }
constexpr unsigned CV_ALL = (1u << NSEG) - 1u;
constexpr unsigned CV_P1 = SEGM(2) | SEGM(12);
constexpr unsigned CV_P4 = SEGM(16) | SEGM(3) | SEGM(4);
constexpr unsigned CV_P8 = SEGM(5) | SEGM(13) | SEGM(14) | SEGM(15) | SEGM(21) | SEGM(22) | SEGM(23) | SEGM(24) | SEGM(17);
constexpr unsigned CV_P14 = SEGM(9) | SEGM(10);
constexpr unsigned CV_P19 = SEGM(11);
constexpr unsigned CV_P0 = CV_ALL & ~(CV_P1 | CV_P4 | CV_P8 | CV_P14 | CV_P19);
__device__ __forceinline__ void prologue(const Ctx& c, const Args& a) {
    convert_segs(c, a, (c.G == 256) ? CV_P0 : CV_ALL, c.bid, c.G);
    const int gw = c.bid * NWAVES + c.wid, NGW = c.G * NWAVES;
    norm_rows(c, (const float*)a.in[0], S, (const float*)a.in[3], (bf16*)(a.ws + WS_XN), nullptr, nullptr, nullptr);
    norm_rows(c, (const float*)a.in[1], NMEM, (const float*)a.in[8], (bf16*)(a.ws + WS_MEMN), (const float*)a.in[8] + D, (bf16*)(a.ws + WS_MEMN + (size_t)NMEM * D * 2), nullptr);
    const int* pos = (const int*)a.in[2]; float* rope = (float*)(a.ws + WS_ROPE);
    for (int i = c.bid * NTHREADS + c.tid; i < S * 16; i += c.G * NTHREADS) { const int t = i >> 4, f = i & 15;
        const double inv = pow(500000.0, -(double)f / 16.0);
        const double ang = (double)pos[t] * inv; rope[t * 32 + f] = (float)cos(ang); rope[t * 32 + 16 + f] = (float)sin(ang); }
    for (int i = c.bid * NTHREADS + c.tid; i < 5 * S; i += c.G * NTHREADS) ((float*)(a.ws + WS_SS))[i] = 0.f;
    for (int i = c.bid * NTHREADS + c.tid; i < 2 * 2048; i += c.G * NTHREADS) { bf16* p = (bf16*)(a.ws + (i < 2048 ? WS_KCR : WS_VCR) + SZ_KR); p[i & 2047] = 0; }
}

typedef short v4i16_t __attribute__((ext_vector_type(4)));
__device__ __forceinline__ s16x4 vtr(LAS const unsigned char* p) { return __builtin_bit_cast(s16x4, __builtin_amdgcn_ds_read_tr16_b64_v4i16((LAS v4i16_t*)p)); }
__device__ __forceinline__ unsigned xr_of(unsigned row) { return ((row & 3u) << 2) | ((row >> 2) & 3u); }
constexpr int KV_BUF = 32768;
constexpr int IMP_OFF = 65536;
constexpr float C1 = 0.08838834764831845f * 1.4426950408889634f;

__device__ __forceinline__ void stage_kv(LAS unsigned char* buf, const bf16* Kg, int ldk, const bf16* Vg, int ldv, int key0, int wid, int lane_in) {
    int lane = lane_in; asm volatile("" : "+v"(lane));
#pragma unroll
    for (int i = 0; i < 2; ++i) {
        const unsigned b = (unsigned)(i * 8192 + wid * 1024 + lane * 16); const unsigned row = b >> 8, pos = (b >> 4) & 15u; const unsigned ch = pos ^ xr_of(row);
        const unsigned chv = pos ^ (2u * (row & 7u));
        __builtin_amdgcn_global_load_lds((const unsigned*)(Kg + (size_t)(key0 + (int)row) * ldk + ch * 8), (LAS unsigned*)(buf + i * 8192 + wid * 1024), 16, 0, 0);
        __builtin_amdgcn_global_load_lds((const unsigned*)(Vg + (size_t)(key0 + (int)row) * ldv + chv * 8), (LAS unsigned*)(buf + 16384 + i * 8192 + wid * 1024), 16, 0, 0);
    }
}

__device__ __forceinline__ float gmax4(float x) { auto a = __builtin_amdgcn_permlane16_swap(__float_as_uint(x), __float_as_uint(x), false, false); x = fmaxf(__uint_as_float(a[0]), __uint_as_float(a[1]));
    auto b = __builtin_amdgcn_permlane32_swap(__float_as_uint(x), __float_as_uint(x), false, false); return fmaxf(__uint_as_float(b[0]), __uint_as_float(b[1])); }
__device__ __forceinline__ float gsum4(float x) { auto a = __builtin_amdgcn_permlane16_swap(__float_as_uint(x), __float_as_uint(x), false, false); x = __uint_as_float(a[0]) + __uint_as_float(a[1]);
    auto b = __builtin_amdgcn_permlane32_swap(__float_as_uint(x), __float_as_uint(x), false, false); return __uint_as_float(b[0]) + __uint_as_float(b[1]); }
struct AX { float linv[3]; float tc; LAS float* impw; bool first; unsigned sel[4]; };

template <int NH, int MODE, bool EMASK, int QS>
__device__ __forceinline__ void attn_tile(LAS const unsigned char* kbuf, LAS const unsigned char* vbuf, const bf16x8 (&Q)[NH][4], f32x4 (&O)[NH][8], float (&m)[NH], float (&l)[NH],
                                          int key0, int T, int t, int lane_in, unsigned csel, AX& ax) {
    constexpr int HV = (NH > 1) ? 2 : 1, KBN = 4 / HV, CN = 2 / HV;
    int lane = lane_in; asm volatile("" : "+v"(lane));
    const int g = lane >> 4, r = lane & 15;
    const unsigned xr = xr_of((unsigned)r);
    const unsigned kbase = 256u * (unsigned)r + 16u * ((unsigned)g ^ (xr & 3u)), xs = xr >> 2;
    const unsigned q = (unsigned)r >> 2, pp = (unsigned)r & 3u;
    const unsigned wv = 4u * ((unsigned)g & 1u) + q;
    const unsigned vrow = 256u * (4u * (unsigned)g + q) + 8u * (pp & 1u) + 16u * (pp >> 1);
    const float NEG = -__builtin_inff();
    float prevc = ax.tc;
#pragma unroll
    for (int hf = 0; hf < HV; ++hf) {
        f32x4 sacc[NH][KBN];
#pragma unroll
        for (int h = 0; h < NH; ++h)
#pragma unroll
            for (int kbl = 0; kbl < KBN; ++kbl) sacc[h][kbl] = (f32x4){0.f, 0.f, 0.f, 0.f};
#pragma unroll
        for (int kbl = 0; kbl < KBN; ++kbl) {
            bf16x8 kf[4];
#pragma unroll
            for (int s = 0; s < 4; ++s) kf[s] = *(LAS const bf16x8*)(kbuf + kbase + 4096u * (hf * KBN + kbl) + 64u * ((unsigned)s ^ xs));
            __builtin_amdgcn_s_setprio(1);
#pragma unroll
            for (int s = 0; s < 4; ++s)
#pragma unroll
                for (int h = 0; h < NH; ++h) sacc[h][kbl] = __builtin_amdgcn_mfma_f32_16x16x32_bf16(kf[s], Q[h][s], sacc[h][kbl], 0, 0, 0);
            __builtin_amdgcn_s_setprio(0);
            if (NH > 1) __builtin_amdgcn_sched_barrier(0);
        }
        bf16x8 pk[NH][CN];
        float mainh[KBN], carh[KBN];
#pragma unroll
        for (int kbl = 0; kbl < KBN; ++kbl) { mainh[kbl] = 0.f; carh[kbl] = 0.f; }
#pragma unroll
        for (int h = 0; h < NH; ++h) {
            const int th = t + QS * h;
            int hi_lim = 1 << 20, lo_lim = -(1 << 20);
            if (MODE == 0 || MODE == 1) hi_lim = ((th - 31) >> 4) - key0 - 4 * g;
            if (MODE == 2 || MODE == 3) hi_lim = th - key0 - 4 * g;
            if (MODE == 3) lo_lim = th - 512 - key0 - 4 * g;
            const float bias = (MODE == 2 && !((csel >> h) & 1u)) ? NEG : 0.f;
            float x[KBN][4]; float mx = NEG;
#pragma unroll
            for (int kbl = 0; kbl < KBN; ++kbl)
#pragma unroll
                for (int i = 0; i < 4; ++i) {
                    float v = sacc[h][kbl][i];
                    if (EMASK) { const int e = 16 * (hf * KBN + kbl) + i; const bool valid = (MODE == 3) ? (e <= hi_lim && e > lo_lim) : (e <= hi_lim); v = valid ? v : NEG; }
                    x[kbl][i] = v; mx = fmaxf(mx, v);
                }
            float p[KBN][4];
            if (MODE == 1) {
                const float nmu = -m[h], li = ax.linv[h];
#pragma unroll
                for (int kbl = 0; kbl < KBN; ++kbl) {
#pragma unroll
                    for (int i = 0; i < 4; ++i) p[kbl][i] = fexp2(fmaf(x[kbl][i], C1, nmu)) * li;
                    mainh[kbl] += (p[kbl][0] + p[kbl][1]) + (p[kbl][2] + 0.5f * p[kbl][3]); carh[kbl] += 0.5f * p[kbl][3];
                }
            } else {
                mx = gmax4(mx);
                mx = mx * C1 + bias;
                const float mn = fmaxf(m[h], mx); const float mu = (mn == NEG) ? 0.f : mn;
                const float alpha = fexp2(m[h] - mu); const float nb_ = bias - mu;
                float ps = 0.f;
#pragma unroll
                for (int kbl = 0; kbl < KBN; ++kbl)
#pragma unroll
                    for (int i = 0; i < 4; ++i) { p[kbl][i] = fexp2(fmaf(x[kbl][i], C1, nb_)); ps += p[kbl][i]; }
                l[h] = l[h] * alpha + ps; m[h] = mn;
                if (MODE != 0) {
                    if (__ballot(alpha != 1.0f) != 0ull) {
#pragma unroll
                        for (int db = 0; db < 8; ++db) O[h][db] = O[h][db] * alpha;
                    }
                }
            }
            if (MODE != 0) {
#pragma unroll
                for (int cl = 0; cl < CN; ++cl) {
                    u32x4 w; w.x = cvt_pk_bf16(p[2 * cl][0], p[2 * cl][1]); w.y = cvt_pk_bf16(p[2 * cl][2], p[2 * cl][3]);
                    w.z = cvt_pk_bf16(p[2 * cl + 1][0], p[2 * cl + 1][1]); w.w = cvt_pk_bf16(p[2 * cl + 1][2], p[2 * cl + 1][3]);
                    pk[h][cl] = __builtin_bit_cast(bf16x8, w);
                }
            }
        }
        if (MODE == 1) {
#pragma unroll
            for (int kbl = 0; kbl < KBN; ++kbl) {
                const float a = __shfl(carh[kbl], (lane - 16) & 63);
                const float b = __shfl(prevc, (lane + 48) & 63);
                const float cp = (g == 0) ? b : a;
                { LAS float* ip = ax.impw + r * 128 + 16 * T + 4 * (hf * KBN + kbl) + g; const float nv = mainh[kbl] + cp; *ip = ax.first ? nv : (*ip + nv); }
                prevc = carh[kbl];
            }
        }
        if (MODE != 0) {
#pragma unroll
            for (int cl = 0; cl < CN; ++cl)
#pragma unroll
                for (int db = 0; db < 8; ++db) {
                    const int cc = hf * CN + cl;
                    const unsigned cho = 32u * ((unsigned)db ^ wv);
                    const s16x4 v0 = vtr(vbuf + vrow + 4096u * (2 * cc) + cho), v1 = vtr(vbuf + vrow + 4096u * (2 * cc + 1) + cho);
                    const bf16x8 vf = {v0[0], v0[1], v0[2], v0[3], v1[0], v1[1], v1[2], v1[3]};
#pragma unroll
                    for (int h = 0; h < NH; ++h) O[h][db] = __builtin_amdgcn_mfma_f32_16x16x32_bf16(vf, pk[h][cl], O[h][db], 0, 0, 0);
                    if (NH > 1 && (db & 3) == 3) __builtin_amdgcn_sched_barrier(0);
                }
        }
    }
    if (MODE == 1) ax.tc = prevc;
}

template <int NH, int MODE>
__device__ __forceinline__ void attn_run(const Ctx& c, const bf16* Kg, int ldk, const bf16* Vg, int ldv, int tile_lo, int tile_hi,
                                         const bf16x8 (&Q)[NH][4], f32x4 (&O)[NH][8], float (&m)[NH], float (&l)[NH], int t, AX& ax) {
    if (tile_lo >= tile_hi) return;
    const int q_lo = __builtin_amdgcn_readfirstlane(t) & ~127;
    constexpr int NBUF = (MODE == 0 || MODE == 1) ? 2 : 4, DIST = NBUF - 1;
    __syncthreads();
#pragma unroll
    for (int d = 0; d < DIST; ++d) if (tile_lo + d < tile_hi) stage_kv(c.lds + d * KV_BUF, Kg, ldk, Vg, ldv, 64 * (tile_lo + d), c.wid, c.lane);
    for (int T = tile_lo; T < tile_hi; ++T) {
        const int cur = (T - tile_lo) & (NBUF - 1);
        if (DIST > 1 && T + DIST - 1 < tile_hi) { if (DIST == 3) asm volatile("s_waitcnt vmcnt(8)" ::: "memory"); else asm volatile("s_waitcnt vmcnt(4)" ::: "memory"); }
        else asm volatile("s_waitcnt vmcnt(0)" ::: "memory");
        __syncthreads();
        if (T + DIST < tile_hi) stage_kv(c.lds + ((T - tile_lo + DIST) & (NBUF - 1)) * KV_BUF, Kg, ldk, Vg, ldv, 64 * (T + DIST), c.wid, c.lane);
        bool colsel = true; bool doit = true;
        if (MODE == 2) {
            const int w = T >> 5; const unsigned word = (w == 0) ? ax.sel[0] : (w == 1) ? ax.sel[1] : (w == 2) ? ax.sel[2] : ax.sel[3];
            colsel = ((word >> (T & 31)) & 1u) != 0u;
            doit = __ballot(colsel) != 0ull;
        }
        bool em = false;
        if (MODE == 0 || MODE == 1) em = (1024 * T + 1039 > q_lo);
        if (MODE == 2) em = (64 * T + 63 > q_lo);
        if (MODE == 3) em = (64 * T + 63 > q_lo) || (64 * T <= q_lo + 127 - 512);
        if (doit) {
            if (em) attn_tile<NH, MODE, true, 0>(c.lds + cur * KV_BUF, c.lds + cur * KV_BUF + 16384, Q, O, m, l, 64 * T, T, t, c.lane, colsel ? 0xffu : 0u, ax);
            else attn_tile<NH, MODE, false, 0>(c.lds + cur * KV_BUF, c.lds + cur * KV_BUF + 16384, Q, O, m, l, 64 * T, T, t, c.lane, colsel ? 0xffu : 0u, ax);
        }
    }
}

__device__ __forceinline__ void load_q(bf16x8 (&Qh)[4], const bf16* rowp, const float* rope_t, int lane) {
    const int g = lane >> 4;
#pragma unroll
    for (int s = 0; s < 4; ++s) Qh[s] = *(const bf16x8*)(rowp + 32 * s + 8 * g);
    if (rope_t) {
        const u32x4 own = __builtin_bit_cast(u32x4, Qh[0]); u32x4 par;
        par.x = __shfl_xor(own.x, 32); par.y = __shfl_xor(own.y, 32); par.z = __shfl_xor(own.z, 32); par.w = __shfl_xor(own.w, 32);
        const int f0 = 8 * (g & 1);
        const f32x4 c0 = *(const f32x4*)(rope_t + f0), c1 = *(const f32x4*)(rope_t + f0 + 4), s0 = *(const f32x4*)(rope_t + 16 + f0), s1 = *(const f32x4*)(rope_t + 16 + f0 + 4);
        const float sg = (g < 2) ? -1.f : 1.f;
        const float o0 = bflo(own.x) * c0.x + sg * bflo(par.x) * s0.x, o1 = bfhi(own.x) * c0.y + sg * bfhi(par.x) * s0.y;
        const float o2 = bflo(own.y) * c0.z + sg * bflo(par.y) * s0.z, o3 = bfhi(own.y) * c0.w + sg * bfhi(par.y) * s0.w;
        const float o4 = bflo(own.z) * c1.x + sg * bflo(par.z) * s1.x, o5 = bfhi(own.z) * c1.y + sg * bfhi(par.z) * s1.y;
        const float o6 = bflo(own.w) * c1.z + sg * bflo(par.w) * s1.z, o7 = bfhi(own.w) * c1.w + sg * bfhi(par.w) * s1.w;
        u32x4 w; w.x = cvt_pk_bf16(o0, o1); w.y = cvt_pk_bf16(o2, o3); w.z = cvt_pk_bf16(o4, o5); w.w = cvt_pk_bf16(o6, o7);
        Qh[0] = __builtin_bit_cast(bf16x8, w);
    }
}
__device__ __forceinline__ float red_g(float v) { return gsum4(v); }
__device__ __forceinline__ float sigmoidf_(float x) { return 1.0f / (1.0f + __expf(-x)); }

__device__ __forceinline__ void nsa_cmp_item(const Ctx& c, const Args& a, int nb, int grp) {
    unsigned char* ws = a.ws;
    const bf16* UNSA = (const bf16*)(ws + WS_UNSA);
    const float* ROPE = (const float*)(ws + WS_ROPE); float* TMP = (float*)(ws + WS_TMP);
    const int lane = c.lane, g = lane >> 4, r = lane & 15;
    const int t = 128 * nb + 16 * c.wid + r;
    const float NEG = -__builtin_inff();
    AX ax; ax.impw = (LAS float*)(c.lds + IMP_OFF) + c.wid * (16 * 128); ax.tc = 0.f; ax.linv[0] = ax.linv[1] = ax.linv[2] = 0.f; ax.first = true; ax.sel[0] = ax.sel[1] = ax.sel[2] = ax.sel[3] = 0u;
    const int nT = (8 * nb + 70) >> 6;
    const bf16* KCC = (const bf16*)(ws + WS_KCC) + (size_t)grp * 512 * 128; const bf16* VCC = (const bf16*)(ws + WS_VCC) + (size_t)grp * 512 * 128;
#pragma unroll 1
    for (int h = 0; h < 3; ++h) {
        const int head = 3 * grp + h;
        bf16x8 Q[1][4]; load_q(Q[0], UNSA + (size_t)t * NNSA + head * 128, ROPE + (size_t)t * 32, lane);
        f32x4 O[1][8]; float m[1], l[1];
        m[0] = NEG; l[0] = 0.f;
#pragma unroll
        for (int db = 0; db < 8; ++db) O[0][db] = (f32x4){0.f, 0.f, 0.f, 0.f};
        attn_run<1, 0>(c, KCC, 128, VCC, 128, 0, nT, Q, O, m, l, t, ax);
        { const float lt = red_g(l[0]); ax.linv[0] = lt > 0.f ? 1.0f / lt : 0.f; m[0] = (m[0] == NEG) ? 0.f : m[0]; }
        ax.tc = 0.f; ax.first = (h == 0);
        attn_run<1, 1>(c, KCC, 128, VCC, 128, 0, nT, Q, O, m, l, t, ax);
        const float gt = sigmoidf_(bf2f(UNSA[(size_t)t * NNSA + 2048 + 3 * head + 0]));
        float* tmpq = TMP + (size_t)t * QW + head * 128 + 4 * g;
#pragma unroll
        for (int db = 0; db < 8; ++db) *(f32x4*)(tmpq + 16 * db) = O[0][db] * gt;
    }
    {
        float v[32];
        int g_ = g; asm volatile("" : "+v"(g_));
        const LAS f32x4* src = (const LAS f32x4*)(ax.impw + r * 128 + 32 * g_);
#pragma unroll
        for (int k4 = 0; k4 < 8; ++k4) { const f32x4 w = src[k4]; v[4 * k4] = w.x; v[4 * k4 + 1] = w.y; v[4 * k4 + 2] = w.z; v[4 * k4 + 3] = w.w; }
        const int jt = t >> 6; const float PINF = __builtin_inff();
#pragma unroll
        for (int k = 0; k < 32; ++k) { const int j = 32 * g_ + k; v[k] = (j == 0 || j == jt || j == jt - 1) ? PINF : ((j > jt) ? NEG : v[k]); }
        unsigned selown = 0u;
#pragma unroll 1
        for (int round = 0; round < 16; ++round) {
            float bv = v[0]; int bk = 0;
#pragma unroll
            for (int k = 1; k < 32; ++k) { const bool gt = v[k] > bv; bv = gt ? v[k] : bv; bk = gt ? k : bk; }
            int bidx = 32 * g_ + bk;
#pragma unroll
            for (int o = 16; o <= 32; o <<= 1) { const float ov = __shfl_xor(bv, o); const int oi = __shfl_xor(bidx, o); const bool take = (ov > bv) || (ov == bv && oi < bidx); bv = take ? ov : bv; bidx = take ? oi : bidx; }
            const bool mine = (bidx >> 5) == g_; const int kk = bidx & 31;
            selown |= mine ? (1u << kk) : 0u;
#pragma unroll
            for (int k = 0; k < 32; ++k) v[k] = (mine && k == kk) ? NEG : v[k];
        }
        ((unsigned*)(ws + WS_SELB))[((size_t)t * 4 + grp) * 4 + g_] = selown;
    }
}

__device__ __forceinline__ void nsa_sw_item(const Ctx& c, const Args& a, int nb, int head) {
    unsigned char* ws = a.ws;
    const bf16* UNSA = (const bf16*)(ws + WS_UNSA); const bf16* UKV = (const bf16*)(ws + WS_UKV);
    const float* ROPE = (const float*)(ws + WS_ROPE); const float* TMP = (const float*)(ws + WS_TMP); bf16* CAT = (bf16*)(ws + WS_CAT);
    const int lane = c.lane, g = lane >> 4, r = lane & 15, grp = head / 3;
    const int t = 128 * nb + 16 * c.wid + r;
    const float NEG = -__builtin_inff();
    AX ax; ax.impw = nullptr; ax.tc = 0.f; ax.linv[0] = ax.linv[1] = ax.linv[2] = 0.f; ax.first = true;
    { const u32x4 sw = *(const u32x4*)((const unsigned*)(ws + WS_SELB) + ((size_t)t * 4 + grp) * 4); ax.sel[0] = sw.x; ax.sel[1] = sw.y; ax.sel[2] = sw.z; ax.sel[3] = sw.w; }
    bf16x8 Q[1][4]; load_q(Q[0], UNSA + (size_t)t * NNSA + head * 128, ROPE + (size_t)t * 32, lane);
    f32x4 O[1][8]; float m[1], l[1];
    m[0] = NEG; l[0] = 0.f;
#pragma unroll
    for (int db = 0; db < 8; ++db) O[0][db] = (f32x4){0.f, 0.f, 0.f, 0.f};
    attn_run<1, 2>(c, (const bf16*)(ws + WS_KSR) + (size_t)grp * S * 128, 128, UKV + 1536 + grp * 128, NKV, 0, 2 * nb + 2, Q, O, m, l, t, ax);
    f32x4 acc[8];
    { const float lt = red_g(l[0]); const float sc = (lt > 0.f ? 1.0f / lt : 0.f) * sigmoidf_(bf2f(UNSA[(size_t)t * NNSA + 2048 + 3 * head + 1]));
      const float* tmpq = TMP + (size_t)t * QW + head * 128 + 4 * g;
#pragma unroll
      for (int db = 0; db < 8; ++db) acc[db] = *(const f32x4*)(tmpq + 16 * db) + O[0][db] * sc; }
    m[0] = NEG; l[0] = 0.f;
#pragma unroll
    for (int db = 0; db < 8; ++db) O[0][db] = (f32x4){0.f, 0.f, 0.f, 0.f};
    attn_run<1, 3>(c, (const bf16*)(ws + WS_KWR) + (size_t)grp * S * 128, 128, UKV + 2560 + grp * 128, NKV, (2 * nb - 8) > 0 ? (2 * nb - 8) : 0, 2 * nb + 2, Q, O, m, l, t, ax);
    { const float lt = red_g(l[0]); const float sc = (lt > 0.f ? 1.0f / lt : 0.f) * sigmoidf_(bf2f(UNSA[(size_t)t * NNSA + 2048 + 3 * head + 2]));
      bf16* catq = CAT + (size_t)t * D + head * 128 + 4 * g;
#pragma unroll
      for (int db = 0; db < 8; ++db) { const f32x4 o = acc[db] + O[0][db] * sc; u32x2 w; w.x = cvt_pk_bf16(o.x, o.y); w.y = cvt_pk_bf16(o.z, o.w); *(u32x2*)(catq + 16 * db) = w; } }
}

struct AX2 { const LAS unsigned* selw; };
constexpr int SELW_OFF = 131072;
template <int MODE>
__device__ __forceinline__ void attn_run2(const Ctx& c, const bf16* Kg, int ldk, const bf16* Vg, int ldv, int tile_lo, int tile_hi,
                                          const bf16x8 (&Q)[2][4], f32x4 (&O)[2][8], float (&m)[2], float (&l)[2], int t0, const AX2& a2, AX& ax, int lane) {
    const int kh = c.wid >> 2, qs = c.wid & 3;
    const int q_lo = __builtin_amdgcn_readfirstlane(t0) & ~127;
    const int npairs = (tile_hi - tile_lo + 1) >> 1;
    __syncthreads();
    if (npairs > 0) { stage_kv(c.lds, Kg, ldk, Vg, ldv, 64 * tile_lo, c.wid, lane); if (tile_lo + 1 < tile_hi) stage_kv(c.lds + KV_BUF, Kg, ldk, Vg, ldv, 64 * (tile_lo + 1), c.wid, lane); }
    for (int pi = 0; pi < npairs; ++pi) {
        const int cur = pi & 1;
        asm volatile("s_waitcnt vmcnt(0)" ::: "memory");
        __syncthreads();
        if (pi + 1 < npairs) { const int Tn = tile_lo + 2 * (pi + 1);
            stage_kv(c.lds + (cur ^ 1) * 2 * KV_BUF, Kg, ldk, Vg, ldv, 64 * Tn, c.wid, lane);
            if (Tn + 1 < tile_hi) stage_kv(c.lds + (cur ^ 1) * 2 * KV_BUF + KV_BUF, Kg, ldk, Vg, ldv, 64 * (Tn + 1), c.wid, lane); }
        const int T = tile_lo + 2 * pi + kh;
        if (T < tile_hi) {
            unsigned csel = 3u; bool doit = true;
            if (MODE == 2) {
                const int w = T >> 5;
                const unsigned w0 = a2.selw[(lane & 15) * 4 + w], w1 = a2.selw[(16 + (lane & 15)) * 4 + w];
                csel = ((w0 >> (T & 31)) & 1u) | (((w1 >> (T & 31)) & 1u) << 1);
                doit = __ballot(csel != 0u) != 0ull;
            }
            bool em = false;
            if (MODE == 2) em = (64 * T + 63 > q_lo);
            if (MODE == 3) em = (64 * T + 63 > q_lo) || (64 * T <= q_lo + 127 - 512);
            LAS unsigned char* kb_ = c.lds + cur * 2 * KV_BUF + kh * KV_BUF;
            if (doit) {
                if (em) attn_tile<2, MODE, true, 16>(kb_, kb_ + 16384, Q, O, m, l, 64 * T, T, t0, lane, csel, ax);
                else attn_tile<2, MODE, false, 16>(kb_, kb_ + 16384, Q, O, m, l, 64 * T, T, t0, lane, csel, ax);
            }
        }
    }
    __syncthreads();
    LAS float* mb = (LAS float*)c.lds + qs * (68 * 64) + lane;
    if (kh == 1) {
#pragma unroll
        for (int b = 0; b < 2; ++b) { mb[(b * 34 + 0) * 64] = m[b]; mb[(b * 34 + 1) * 64] = l[b];
#pragma unroll
            for (int db = 0; db < 8; ++db) { mb[(b * 34 + 2 + 4 * db) * 64] = O[b][db].x; mb[(b * 34 + 3 + 4 * db) * 64] = O[b][db].y; mb[(b * 34 + 4 + 4 * db) * 64] = O[b][db].z; mb[(b * 34 + 5 + 4 * db) * 64] = O[b][db].w; } }
    }
    __syncthreads();
    if (kh == 0) {
        const float NEG = -__builtin_inff();
#pragma unroll
        for (int b = 0; b < 2; ++b) { const float mo = mb[(b * 34 + 0) * 64], lo_ = mb[(b * 34 + 1) * 64];
            const float mn = fmaxf(m[b], mo); const float mu = (mn == NEG) ? 0.f : mn; const float sa = fexp2(m[b] - mu), sb = fexp2(mo - mu);
            l[b] = l[b] * sa + lo_ * sb; m[b] = mn;
#pragma unroll
            for (int db = 0; db < 8; ++db) { f32x4 o; o.x = mb[(b * 34 + 2 + 4 * db) * 64]; o.y = mb[(b * 34 + 3 + 4 * db) * 64]; o.z = mb[(b * 34 + 4 + 4 * db) * 64]; o.w = mb[(b * 34 + 5 + 4 * db) * 64];
                O[b][db] = O[b][db] * sa + o * sb; } }
    }
}

__device__ __forceinline__ void nsa_sw_item2(const Ctx& c, const Args& a, int nb, int head) {
    unsigned char* ws = a.ws;
    const bf16* UNSA = (const bf16*)(ws + WS_UNSA); const bf16* UKV = (const bf16*)(ws + WS_UKV);
    const float* ROPE = (const float*)(ws + WS_ROPE); float* TMP = (float*)(ws + WS_TMP); bf16* CAT = (bf16*)(ws + WS_CAT);
    int lane = c.lane; asm volatile("" : "+v"(lane));
    const int g = lane >> 4, r = lane & 15, grp = head / 3, kh = c.wid >> 2, qs = c.wid & 3;
    const int t0 = 128 * nb + 32 * qs + r;
    const float NEG = -__builtin_inff();
    AX ax; ax.impw = nullptr; ax.tc = 0.f; ax.linv[0] = ax.linv[1] = ax.linv[2] = 0.f; ax.first = true; ax.sel[0] = ax.sel[1] = ax.sel[2] = ax.sel[3] = 0u;
    AX2 a2; a2.selw = (const LAS unsigned*)(c.lds + SELW_OFF) + (32 * qs) * 4;
    bf16x8 Q[2][4];
#pragma unroll
    for (int b = 0; b < 2; ++b) { const int tb = t0 + 16 * b;
        ((LAS unsigned*)(c.lds + SELW_OFF))[(32 * qs + 16 * b + r) * 4 + g] = ((const unsigned*)(ws + WS_SELB))[((size_t)tb * 4 + grp) * 4 + g];
        load_q(Q[b], UNSA + (size_t)tb * NNSA + head * 128, ROPE + (size_t)tb * 32, lane); }
    f32x4 O[2][8]; float m[2], l[2];
#pragma unroll
    for (int b = 0; b < 2; ++b) { m[b] = NEG; l[b] = 0.f;
#pragma unroll
        for (int db = 0; db < 8; ++db) O[b][db] = (f32x4){0.f, 0.f, 0.f, 0.f}; }
    attn_run2<2>(c, (const bf16*)(ws + WS_KSR) + (size_t)grp * S * 128, 128, UKV + 1536 + grp * 128, NKV, 0, 2 * nb + 2, Q, O, m, l, t0, a2, ax, lane);
    if (kh == 0) {
#pragma unroll
        for (int b = 0; b < 2; ++b) { const int tb = t0 + 16 * b; const float lt = red_g(l[b]); const float sc = (lt > 0.f ? 1.0f / lt : 0.f) * sigmoidf_(bf2f(UNSA[(size_t)tb * NNSA + 2048 + 3 * head + 1]));
            float* tmpq = TMP + (size_t)tb * QW + head * 128 + 4 * g;
#pragma unroll
            for (int db = 0; db < 8; ++db) { f32x4* p = (f32x4*)(tmpq + 16 * db); *p = *p + O[b][db] * sc; } }
    }
#pragma unroll
    for (int b = 0; b < 2; ++b) { m[b] = NEG; l[b] = 0.f;
#pragma unroll
        for (int db = 0; db < 8; ++db) O[b][db] = (f32x4){0.f, 0.f, 0.f, 0.f}; }
    attn_run2<3>(c, (const bf16*)(ws + WS_KWR) + (size_t)grp * S * 128, 128, UKV + 2560 + grp * 128, NKV, (2 * nb - 8) > 0 ? (2 * nb - 8) : 0, 2 * nb + 2, Q, O, m, l, t0, a2, ax, lane);
    if (kh == 0) {
#pragma unroll
        for (int b = 0; b < 2; ++b) { const int tb = t0 + 16 * b; const float lt = red_g(l[b]); const float sc = (lt > 0.f ? 1.0f / lt : 0.f) * sigmoidf_(bf2f(UNSA[(size_t)tb * NNSA + 2048 + 3 * head + 2]));
            const float* tmpq = TMP + (size_t)tb * QW + head * 128 + 4 * g; bf16* catq = CAT + (size_t)tb * D + head * 128 + 4 * g;
#pragma unroll
            for (int db = 0; db < 8; ++db) { const f32x4 o = *(const f32x4*)(tmpq + 16 * db) + O[b][db] * sc; u32x2 w; w.x = cvt_pk_bf16(o.x, o.y); w.y = cvt_pk_bf16(o.z, o.w); *(u32x2*)(catq + 16 * db) = w; } }
    }
}

__device__ __forceinline__ void mem_item(const Ctx& c, const Args& a, const bf16* qsrc, int ldq, int qcol, const bf16* memkv, int qb, int head) {
    const int lane = c.lane, g = lane >> 4, r = lane & 15;
    const int t = 128 * qb + 16 * c.wid + r;
    bf16x8 Q[1][4]; load_q(Q[0], qsrc + (size_t)t * ldq + qcol + head * 128, nullptr, lane);
    f32x4 O[1][8]; float m[1], l[1]; AX ax; ax.impw = nullptr; ax.first = true; ax.sel[0] = ax.sel[1] = ax.sel[2] = ax.sel[3] = 0u; ax.tc = 0.f; ax.linv[0] = ax.linv[1] = ax.linv[2] = 0.f;
    m[0] = -__builtin_inff(); l[0] = 0.f;
#pragma unroll
    for (int db = 0; db < 8; ++db) O[0][db] = (f32x4){0.f, 0.f, 0.f, 0.f};
    attn_run<1, 4>(c, memkv + head * 128, MEMKVW, memkv + 512 + head * 128, MEMKVW, 0, NMEM / 64, Q, O, m, l, t, ax);
    const float lt = red_g(l[0]); const float sc = lt > 0.f ? 1.0f / lt : 0.f;
    bf16* catq = (bf16*)(a.ws + WS_CAT) + (size_t)t * D + QW + head * 128 + 4 * g;
#pragma unroll
    for (int db = 0; db < 8; ++db) { const f32x4 o = O[0][db] * sc; u32x2 w; w.x = cvt_pk_bf16(o.x, o.y); w.y = cvt_pk_bf16(o.z, o.w); *(u32x2*)(catq + 16 * db) = w; }
}

__device__ __forceinline__ void unpack8(const u32x4 w, float (&f)[8]) { f[0] = bflo(w.x); f[1] = bfhi(w.x); f[2] = bflo(w.y); f[3] = bfhi(w.y); f[4] = bflo(w.z); f[5] = bfhi(w.z); f[6] = bflo(w.w); f[7] = bfhi(w.w); }
__device__ __forceinline__ u32x4 pack8(const float (&f)[8]) { u32x4 w; w.x = cvt_pk_bf16(f[0], f[1]); w.y = cvt_pk_bf16(f[2], f[3]); w.z = cvt_pk_bf16(f[4], f[5]); w.w = cvt_pk_bf16(f[6], f[7]); return w; }

__device__ __forceinline__ void conv_phase(const Ctx& c, const Args& a) {
    const bf16* U = (const bf16*)(a.ws + WS_UCONV); bf16* CAT = (bf16*)(a.ws + WS_CAT); const float* cw = (const float*)a.in[12];
    for (int idx = c.bid * NTHREADS + c.tid; idx < S * (CONVC / 8); idx += c.G * NTHREADS) {
        const int t = idx / (CONVC / 8), ch = (idx - t * (CONVC / 8)) * 8;
        float acc[8] = {0.f, 0.f, 0.f, 0.f, 0.f, 0.f, 0.f, 0.f};
#pragma unroll
        for (int k = 0; k < 3; ++k) { const int tt = t - 2 + k;
            if (tt >= 0) { float gc[8], hv[8]; unpack8(*(const u32x4*)(U + (size_t)tt * NCONV + CONVC + ch), gc); unpack8(*(const u32x4*)(U + (size_t)tt * NCONV + 2 * CONVC + ch), hv);
                const f32x4 w0 = *(const f32x4*)(cw + k * CONVC + ch), w1 = *(const f32x4*)(cw + k * CONVC + ch + 4);
                acc[0] += w0.x * (gc[0] * hv[0]); acc[1] += w0.y * (gc[1] * hv[1]); acc[2] += w0.z * (gc[2] * hv[2]); acc[3] += w0.w * (gc[3] * hv[3]);
                acc[4] += w1.x * (gc[4] * hv[4]); acc[5] += w1.y * (gc[5] * hv[5]); acc[6] += w1.z * (gc[6] * hv[6]); acc[7] += w1.w * (gc[7] * hv[7]); } }
        float gb[8]; unpack8(*(const u32x4*)(U + (size_t)t * NCONV + ch), gb);
#pragma unroll
        for (int j = 0; j < 8; ++j) acc[j] *= gb[j];
        *(u32x4*)(CAT + (size_t)t * D + ch) = pack8(acc);
    }
}

__device__ __forceinline__ void kvpost_phase(const Ctx& c, const Args& a) {
    const bf16* UKV = (const bf16*)(a.ws + WS_UKV); const float* ROPE = (const float*)(a.ws + WS_ROPE);
    for (int idx = c.bid * NTHREADS + c.tid; idx < S * 256; idx += c.G * NTHREADS) {
        const int t = idx >> 8, rem = idx & 255, which = rem >> 6, grp = (rem >> 4) & 3, ch = rem & 15;
        const int colbase = (which == 0) ? 0 : (which == 1) ? 512 : (which == 2) ? 1024 : 2048;
        const size_t dsto = (which == 0) ? WS_KCR : (which == 1) ? WS_VCR : (which == 2) ? WS_KSR : WS_KWR;
        const bf16* src = UKV + (size_t)t * NKV + colbase + grp * 128;
        bf16* dst = (bf16*)(a.ws + dsto) + ((size_t)grp * S + t) * 128;
        u32x4 own = *(const u32x4*)(src + 8 * ch);
        if (which != 1 && ch < 4) {
            const u32x4 par = *(const u32x4*)(src + 8 * (ch ^ 2));
            float xo[8], xp[8], o[8]; unpack8(own, xo); unpack8(par, xp);
            const float* rt = ROPE + (size_t)t * 32 + 8 * (ch & 1); const float sg = (ch < 2) ? -1.f : 1.f;
#pragma unroll
            for (int j = 0; j < 8; ++j) o[j] = xo[j] * rt[j] + sg * xp[j] * rt[16 + j];
            own = pack8(o);
        }
        *(u32x4*)(dst + 8 * ch) = own;
    }
}

__device__ __forceinline__ float gelu_tanh(float x) { const float y = 0.7978845608028654f * (x + 0.044715f * x * x * x); const float e = __expf(2.0f * y); const float th = 1.0f - 2.0f / (e + 1.0f); return 0.5f * x * (1.0f + th); }
__device__ __forceinline__ void compress_item(const Ctx& c, const bf16* src, const float* pos, const bf16* w1t, const bf16* w2t, bf16* dst, int rg) {
    const int lane = c.lane, g = lane >> 4, r = lane & 15, wid = c.wid;
    const int mrow = 16 * rg + r;
    const bf16* arow = src + (size_t)mrow * 2048;
    f32x4 acc[8];
#pragma unroll
    for (int nb = 0; nb < 8; ++nb) acc[nb] = (f32x4){0.f, 0.f, 0.f, 0.f};
#pragma unroll 2
    for (int ks = 0; ks < 16; ++ks) {
        const int k = 512 * wid + 32 * ks + 8 * g;
        float xa[8]; unpack8(*(const u32x4*)(arow + k), xa);
        const f32x4 p0 = *(const f32x4*)(pos + k), p1 = *(const f32x4*)(pos + k + 4);
        xa[0] += p0.x; xa[1] += p0.y; xa[2] += p0.z; xa[3] += p0.w; xa[4] += p1.x; xa[5] += p1.y; xa[6] += p1.z; xa[7] += p1.w;
        const bf16x8 xb = __builtin_bit_cast(bf16x8, pack8(xa));
#pragma unroll
        for (int nb = 0; nb < 8; ++nb) { const bf16x8 wf = *(const bf16x8*)(w1t + (size_t)(16 * nb + r) * 4096 + k); acc[nb] = __builtin_amdgcn_mfma_f32_16x16x32_bf16(wf, xb, acc[nb], 0, 0, 0); }
    }
    LAS f32x4* red = (LAS f32x4*)c.lds;
    __syncthreads();
#pragma unroll
    for (int nb = 0; nb < 8; ++nb) red[(wid * 8 + nb) * 64 + lane] = acc[nb];
    __syncthreads();
    if (wid == 0) {
        float hid[8][4];
#pragma unroll
        for (int nb = 0; nb < 8; ++nb) { f32x4 s = red[nb * 64 + lane];
#pragma unroll
            for (int w = 1; w < 8; ++w) s = s + red[(w * 8 + nb) * 64 + lane];
            hid[nb][0] = gelu_tanh(s.x); hid[nb][1] = gelu_tanh(s.y); hid[nb][2] = gelu_tanh(s.z); hid[nb][3] = gelu_tanh(s.w); }
        f32x4 o2[8];
#pragma unroll
        for (int ob = 0; ob < 8; ++ob) o2[ob] = (f32x4){0.f, 0.f, 0.f, 0.f};
#pragma unroll
        for (int cc = 0; cc < 4; ++cc) {
            u32x4 bw; bw.x = cvt_pk_bf16(hid[2 * cc][0], hid[2 * cc][1]); bw.y = cvt_pk_bf16(hid[2 * cc][2], hid[2 * cc][3]); bw.z = cvt_pk_bf16(hid[2 * cc + 1][0], hid[2 * cc + 1][1]); bw.w = cvt_pk_bf16(hid[2 * cc + 1][2], hid[2 * cc + 1][3]);
            const bf16x8 bfrag = __builtin_bit_cast(bf16x8, bw);
#pragma unroll
            for (int ob = 0; ob < 8; ++ob) { const bf16* wr_ = w2t + (size_t)(16 * ob + r) * 128 + 32 * cc + 4 * g;
                const u32x2 a0 = *(const u32x2*)wr_, a1 = *(const u32x2*)(wr_ + 16);
                u32x4 aw; aw.x = a0.x; aw.y = a0.y; aw.z = a1.x; aw.w = a1.y;
                o2[ob] = __builtin_amdgcn_mfma_f32_16x16x32_bf16(__builtin_bit_cast(bf16x8, aw), bfrag, o2[ob], 0, 0, 0); }
        }
#pragma unroll
        for (int ob = 0; ob < 8; ++ob) { u32x2 w; w.x = cvt_pk_bf16(o2[ob].x, o2[ob].y); w.y = cvt_pk_bf16(o2[ob].z, o2[ob].w); *(u32x2*)(dst + (size_t)mrow * 128 + 16 * ob + 4 * g) = w; }
    }
}

#define XB_TMO      128
#define XB_XCNT(j)  (256  + 64 * (j))
#define XB_XSUB(j)  (1280 + 64 * (j))
#define XB_XGEN(j)  (2304 + 64 * (j))
#define XB_TOP      3328
#define XB_TOPGEN   3392
#define XCD_BAR_WORDS 3456
#define XB_SPIN_CAP (1u << 18)

__device__ __forceinline__ unsigned xb_ld(unsigned* p)              { return __hip_atomic_load(p, __ATOMIC_RELAXED, __HIP_MEMORY_SCOPE_AGENT); }
__device__ __forceinline__ unsigned xb_add(unsigned* p, unsigned v) { return __hip_atomic_fetch_add(p, v, __ATOMIC_RELAXED, __HIP_MEMORY_SCOPE_AGENT); }
__device__ __forceinline__ unsigned xb_xcc_id() { return (unsigned)__builtin_amdgcn_s_getreg((3 << 11) | 20) & 0xFu; }
#define XB_SPIN(cond, bar) do { unsigned _sp = 0; while (cond) { __builtin_amdgcn_s_sleep(1); \
    if ((++_sp & 255u) == 0u) { if (xb_ld(&(bar)[XB_TMO])) break; if (_sp > XB_SPIN_CAP) { atomicAdd(&(bar)[XB_TMO], 1u); break; } } } } while (0)

struct XcdBarrier {
    unsigned* bar; unsigned x;
    volatile LAS unsigned* st;
};

__device__ __forceinline__ XcdBarrier xcd_barrier_post(unsigned* bar, volatile LAS unsigned* st) {
    XcdBarrier b; b.bar = bar; b.x = xb_xcc_id(); b.st = st;
    if (threadIdx.x == 0) (void)xb_add(&bar[XB_XCNT(b.x)], 1u);
    return b;
}
__device__ __forceinline__ void xcd_barrier_complete(unsigned* bar, unsigned x, unsigned& nloc, unsigned& nx) {
    const unsigned G = gridDim.x * gridDim.y * gridDim.z;
    unsigned sum, cnt, mine, sp = 0u;
    for (;;) {
        sum = 0u; cnt = 0u; mine = 0u;
#pragma unroll
        for (unsigned j = 0; j < 16; ++j) { const unsigned c = xb_ld(&bar[XB_XCNT(j)]); sum += c; cnt += (c > 0u) ? 1u : 0u; mine = (j == x) ? c : mine; }
        if (sum == G) break;
        __builtin_amdgcn_s_sleep(1);
        if ((++sp & 255u) == 0u) { if (xb_ld(&bar[XB_TMO])) break; if (sp > XB_SPIN_CAP) { atomicAdd(&bar[XB_TMO], 1u); break; } }
    }
    nloc = mine > 0u ? mine : 1u; nx = cnt > 0u ? cnt : 1u;
}

__device__ __forceinline__ void xcd_barrier(const XcdBarrier& b) {
    asm volatile("s_waitcnt vmcnt(0)" ::: "memory");
    __syncthreads();
    if (threadIdx.x == 0) {
        unsigned* bar = b.bar;
        __builtin_amdgcn_s_waitcnt(0);
        unsigned nloc = b.st[0], nx = b.st[1];
        if (nloc == 0u) { xcd_barrier_complete(bar, b.x, nloc, nx); b.st[0] = nloc; b.st[1] = nx; }
        const unsigned old = xb_add(&bar[XB_XSUB(b.x)], 1u);
        const unsigned gen = old / nloc;
        if (old + 1u == (gen + 1u) * nloc) {
            __builtin_amdgcn_fence(__ATOMIC_RELEASE, "agent");
            asm volatile("s_waitcnt vmcnt(0)" ::: "memory");
            const unsigned og = xb_add(&bar[XB_TOP], 1u);
            const unsigned tg = og / nx;
            if (og + 1u == (tg + 1u) * nx) xb_add(&bar[XB_TOPGEN], 1u);
            else XB_SPIN(xb_ld(&bar[XB_TOPGEN]) == tg, bar);
            __builtin_amdgcn_fence(__ATOMIC_ACQUIRE, "agent");
            xb_add(&bar[XB_XGEN(b.x)], 1u);
            asm volatile("s_waitcnt vmcnt(0)" ::: "memory");
        } else {
            XB_SPIN(xb_ld(&bar[XB_XGEN(b.x)]) == gen, bar);
            __builtin_amdgcn_fence(__ATOMIC_ACQUIRE, "agent");
            asm volatile("s_waitcnt vmcnt(0)" ::: "memory");
        }
    }
    __syncthreads();
}

constexpr int MISC_OFF = 131072 + 2048;
__device__ const unsigned short SW_OFF[257] = {0,2,4,6,8,10,12,14,16,18,20,22,24,26,28,30,32,34,36,38,40,42,44,46,48,50,52,54,56,58,60,62,64,66,68,70,72,74,76,78,80,82,84,86,88,90,92,94,96,98,100,102,104,106,108,110,112,114,116,118,120,122,124,126,128,130,132,134,136,138,140,142,144,146,148,150,152,154,156,158,160,162,164,166,168,170,172,174,176,178,180,182,184,186,188,190,192,194,196,198,200,202,204,206,208,210,212,214,216,218,220,222,224,226,228,230,232,234,236,238,240,242,244,246,248,250,252,254,256,258,260,262,264,266,268,270,272,274,276,278,280,282,284,286,288,290,292,294,296,298,300,302,304,306,308,310,312,316,320,324,328,333,338,343,348,353,358,363,368,372,376,380,384,389,394,399,404,409,414,419,424,428,432,436,440,445,450,455,460,465,470,475,480,484,488,492,496,501,506,511,516,521,526,531,536,540,544,548,552,557,562,567,572,577,582,587,592,596,600,604,608,613,618,623,628,633,638,643,648,652,656,660,664,669,674,679,684,689,694,699,704,708,712,716,720,724,728,732,736,740,744,748,752,756,760,764,768};
__device__ const unsigned short SW_TAB[768] = {0,300,1,301,2,302,3,303,4,304,5,305,6,306,7,307,8,308,9,309,10,310,11,311,12,288,13,289,14,290,15,291,16,292,17,293,18,294,19,295,20,296,21,297,22,298,23,299,24,276,25,277,26,278,27,279,28,280,29,281,30,282,31,283,32,284,33,285,34,286,35,287,36,264,37,265,38,266,39,267,40,268,41,269,42,270,43,271,44,272,45,273,46,274,47,275,48,252,49,253,50,254,51,255,52,256,53,257,54,258,55,259,56,260,57,261,58,262,59,263,60,240,61,241,62,242,63,243,64,244,65,245,66,246,67,247,68,248,69,249,70,250,71,251,72,228,73,229,74,230,75,231,76,232,77,233,78,234,79,235,80,236,81,237,82,238,83,239,84,216,85,217,86,218,87,219,88,220,89,221,90,222,91,223,92,224,93,225,94,226,95,227,96,204,97,205,98,206,99,207,100,208,101,209,102,210,103,211,104,212,105,213,106,214,107,215,108,192,109,193,110,194,111,195,112,196,113,197,114,198,115,199,116,200,117,201,118,202,119,203,120,180,121,181,122,182,123,183,124,184,125,185,126,186,127,187,128,188,129,189,130,190,131,191,132,168,133,169,134,170,135,171,136,172,137,173,138,174,139,175,140,176,141,177,142,178,143,179,144,156,145,157,146,158,147,159,148,160,149,161,150,162,151,163,152,164,153,165,154,166,155,167,312,500,524,640,313,501,525,641,314,502,526,642,315,503,527,643,316,512,600,708,712,317,513,601,709,713,318,514,602,710,714,319,515,603,711,715,320,516,604,696,716,321,517,605,697,717,322,518,606,698,718,323,519,607,699,719,324,488,528,644,325,489,529,645,326,490,530,646,327,491,531,647,328,492,576,700,720,329,493,577,701,721,330,494,578,702,722,331,495,579,703,723,332,496,580,704,724,333,497,581,705,725,334,498,582,706,726,335,499,583,707,727,336,476,532,624,337,477,533,625,338,478,534,626,339,479,535,627,340,480,584,684,728,341,481,585,685,729,342,482,586,686,730,343,483,587,687,731,344,484,588,688,732,345,485,589,689,733,346,486,590,690,734,347,487,591,691,735,348,464,536,628,349,465,537,629,350,466,538,630,351,467,539,631,352,468,592,692,736,353,469,593,693,737,354,470,594,694,738,355,471,595,695,739,356,472,596,672,740,357,473,597,673,741,358,474,598,674,742,359,475,599,675,743,360,452,540,632,361,453,541,633,362,454,542,634,363,455,543,635,364,456,544,676,744,365,457,545,677,745,366,458,546,678,746,367,459,547,679,747,368,460,548,680,748,369,461,549,681,749,370,462,550,682,750,371,463,551,683,751,372,440,568,612,373,441,569,613,374,442,570,614,375,443,571,615,376,444,552,660,752,377,445,553,661,753,378,446,554,662,754,379,447,555,663,755,380,448,556,664,756,381,449,557,665,757,382,450,558,666,758,383,451,559,667,759,384,428,572,616,385,429,573,617,386,430,574,618,387,431,575,619,388,432,560,668,760,389,433,561,669,761,390,434,562,670,762,391,435,563,671,763,392,436,564,648,764,393,437,565,649,765,394,438,566,650,766,395,439,567,651,767,396,416,608,620,397,417,609,621,398,418,610,622,399,419,611,623,400,420,504,652,401,421,505,653,402,422,506,654,403,423,507,655,404,424,508,656,405,425,509,657,406,426,510,658,407,427,511,659,408,412,520,636,409,413,521,637,410,414,522,638,411,415,523,639};
#ifndef REPEAT_MASK
#define REPEAT_MASK 0u
#endif
__device__ __forceinline__ bool refresh(Ctx& c, int rep) { if (rep) __syncthreads(); int tid = threadIdx.x; asm volatile("" : "+v"(tid)); c.tid = tid; c.lane = tid & 63; return true; }
__global__ void __launch_bounds__(NTHREADS) fwd_megakernel(Args a) {
    extern __shared__ __attribute__((aligned(16))) unsigned char lds_raw[];
    __builtin_assume(__builtin_amdgcn_workitem_id_y() == 0); __builtin_assume(__builtin_amdgcn_workitem_id_z() == 0);
    cg::grid_group grid = cg::this_grid();
    Ctx c; c.lds = (LAS unsigned char*)lds_raw; c.tid = threadIdx.x; c.lane = c.tid & 63; c.wid = __builtin_amdgcn_readfirstlane(c.tid >> 6); c.G = gridDim.x; c.bid = blockIdx.x;
    unsigned char* ws = a.ws;
    const float* x = (const float*)a.in[0];
    float* SS = (float*)(ws + WS_SS); const float* kv_norm = (const float*)a.in[14];
    float* H = (float*)(ws + WS_H); bf16* XN = (bf16*)(ws + WS_XN); bf16* XKV = (bf16*)(ws + WS_XKV); bf16* ACT = (bf16*)(ws + WS_ACT);
    bf16* UCONV = (bf16*)(ws + WS_UCONV); bf16* UNSA = (bf16*)(ws + WS_UNSA); bf16* UKV = (bf16*)(ws + WS_UKV); bf16* CAT = (bf16*)(ws + WS_CAT);
    const float* ffn_norm = (const float*)a.in[3]; const float* mix_norm = (const float*)a.in[7];
    const int lo = a.ph_lo, hi = a.ph_hi;
    volatile LAS unsigned* MISC = (volatile LAS unsigned*)(c.lds + MISC_OFF);
    if (c.tid < 2) MISC[c.tid] = 0u;
    __syncthreads();
    XcdBarrier bar; bar.bar = (unsigned*)(ws + WS_CTL); bar.x = 0; bar.st = MISC;
    if (hi - lo > 1) bar = xcd_barrier_post((unsigned*)(ws + WS_CTL), MISC);
    const int rc = c.G - 1 - c.bid;
#define PH(k) if (lo <= (k) && (k) < hi) for (int rep_ = 0; rep_ <= (int)((REPEAT_MASK >> (k)) & 1u); ++rep_) if (refresh(c, rep_))
#define SYNC(k) if (lo <= (k) && (k) + 1 < hi) { xcd_barrier(bar); }
#define WGU(f) ((const bf16*)(ws + WS_WGU + (size_t)(f) * SZ_WGU))
#define WD(f) ((const bf16*)(ws + WS_WD + (size_t)(f) * SZ_WD))
    if (hi < 0) grid.sync();
    PH(0) { prologue(c, a); } SYNC(0)
    PH(1) { run_gemm(c, XN, WGU(0), S, NGU, D, EpiSwiGLU{ACT, FF}, c.bid);
            run_gemm(c, (const bf16*)(ws + WS_MEMN), (const bf16*)(ws + WS_WMEM), NMEM, MEMKVW, D, EpiPlain{(bf16*)(ws + WS_MEMKV), MEMKVW}, rc);
            run_gemm(c, (const bf16*)(ws + WS_MEMN + (size_t)NMEM * D * 2), (const bf16*)(ws + WS_WMEM + (size_t)MEMKVW * D * 2), NMEM, MEMKVW, D, EpiPlain{(bf16*)(ws + WS_MEMKV + (size_t)NMEM * MEMKVW * 2), MEMKVW}, (rc + c.G - 4) % c.G);
            if (c.G == 256 && c.bid >= 128 && c.bid < 248) convert_segs(c, a, CV_P1, c.bid - 128, 120); } SYNC(1)
    PH(2) { run_gemm(c, ACT, WD(0), S, D, FF, EpiRes{x, H, D, 0.5f, SS, XN}, c.bid); } SYNC(2)
    PH(4) { run_gemm(c, XN, (const bf16*)(ws + WS_WCONV), S, NCONV, D, EpiPlain{UCONV, NCONV, SS}, c.bid);
            if (c.G == 256 && c.bid >= 128) convert_segs(c, a, CV_P4, c.bid - 128, 128); } SYNC(4)
    PH(5) { conv_phase(c, a);
            for (int it = c.bid; it < 256; it += c.G) mem_item(c, a, UCONV, NCONV, 3 * CONVC, (const bf16*)(ws + WS_MEMKV), it >> 2, it & 3); } SYNC(5)
    PH(6) { run_gemm(c, CAT, (const bf16*)(ws + WS_WOUT), S, D, D, EpiRes{H, H, D, 1.0f, SS + S, XN}, c.bid); } SYNC(6)
    PH(8) { run_gemm(c, XN, WGU(1), S, NGU, D, EpiSwiGLU{ACT, FF, SS + S}, c.bid);
            if (c.G == 256 && c.bid >= 128) convert_segs(c, a, CV_P8, c.bid - 128, 128); } SYNC(8)
    PH(9) { run_gemm(c, ACT, WD(1), S, D, FF, EpiRes{H, H, D, 0.5f, SS + 2 * S, XN}, c.bid); } SYNC(9)
    PH(11) { run_gemm(c, XN, WGU(2), S, NGU, D, EpiSwiGLU{ACT, FF, SS + 2 * S}, c.bid);
             run_gemm(c, XN, (const bf16*)(ws + WS_WKV), S, NKV, D, EpiPlain{UKV, NKV, SS + 2 * S}, rc); } SYNC(11)
    PH(12) { run_gemm(c, ACT, WD(2), S, D, FF, EpiRes{H, H, D, 0.5f, SS + 3 * S, XN}, c.bid); kvpost_phase(c, a); } SYNC(12)
    PH(14) { run_gemm(c, XN, (const bf16*)(ws + WS_WNSA), S, NNSA, D, EpiPlain{UNSA, NNSA, SS + 3 * S}, c.bid);
             const int nfree = (c.G > 64) ? c.G - 32 : c.G, b0 = (c.G > 64) ? c.bid - 32 : c.bid;
             for (int it = b0; it >= 0 && it < 256; it += nfree) { const int w = it >> 7;
                 compress_item(c, (const bf16*)(ws + (w ? WS_VCR : WS_KCR)), (const float*)a.in[w ? 19 : 16], (const bf16*)(ws + WS_W1C + (size_t)w * 128 * 4096 * 2),
                               (const bf16*)(ws + WS_W2C + (size_t)w * 128 * 128 * 2), (bf16*)(ws + (w ? WS_VCC : WS_KCC)), it & 127); }
             if (c.G == 256 && c.bid >= 32) { __syncthreads(); convert_segs(c, a, CV_P14, c.bid - 32, 224); } } SYNC(14)
    PH(15) { for (int it = c.bid; it < 256; it += c.G) nsa_cmp_item(c, a, 63 - (it >> 2), it & 3);
             if (c.G == 256) { if (c.bid >= 128) for (int it = 2 * (c.bid - 128); it < 2 * (c.bid - 128) + 2; ++it) mem_item(c, a, UNSA, NNSA, QW, (const bf16*)(ws + WS_MEMKV + (size_t)NMEM * MEMKVW * 2), it >> 2, it & 3); }
             else { for (int it = c.bid; it < 256; it += c.G) mem_item(c, a, UNSA, NNSA, QW, (const bf16*)(ws + WS_MEMKV + (size_t)NMEM * MEMKVW * 2), it >> 2, it & 3); } } SYNC(15)
    PH(16) { const int vb = (c.bid & 7) * 32 + (c.bid >> 3);
             const int k0 = (c.G == 256) ? (int)SW_OFF[vb] : c.bid, k1 = (c.G == 256) ? (int)SW_OFF[vb + 1] : 768, kst = (c.G == 256) ? 1 : c.G;
             for (int k = k0; k < k1; k += kst) { const int i = (c.G == 256) ? (int)SW_TAB[k] : k;
                 nsa_sw_item2(c, a, 63 - i / 12, i % 12); } } SYNC(16)
    PH(17) { run_gemm(c, CAT, (const bf16*)(ws + WS_WOUT + (size_t)D * D * 2), S, D, D, EpiRes{H, H, D, 1.0f, SS + 4 * S, XN}, c.bid); } SYNC(17)
    PH(19) { run_gemm(c, XN, WGU(3), S, NGU, D, EpiSwiGLU{ACT, FF, SS + 4 * S}, c.bid);
             if (c.G == 256 && c.bid >= 128) convert_segs(c, a, CV_P19, c.bid - 128, 128); } SYNC(19)
    PH(20) { run_gemm(c, ACT, WD(3), S, D, FF, EpiRes{H, H, D, 0.5f}, c.bid); } SYNC(20)
    PH(21) { norm_rows(c, H, S, (const float*)a.in[22], nullptr, nullptr, nullptr, a.out); }
#undef PH
#undef SYNC
}

extern "C" void kernel_launch(void* const* d_in, const int* in_sizes, int n_in, void* d_out, int out_size, void* d_ws, size_t ws_size, hipStream_t stream) {
    static int grid = 0;
    if (grid == 0) {
        if (n_in != 23 || out_size != S * D || ws_size < WS_END) { fprintf(stderr, "kernel_launch: unexpected problem (n_in %d, out %d, ws %zu < %zu)\n", n_in, out_size, ws_size, (size_t)WS_END); grid = -1; return; }
        int dev = 0, cus = 0, per_cu = 0;
        hipGetDevice(&dev); hipDeviceGetAttribute(&cus, hipDeviceAttributeMultiprocessorCount, dev);
        if (hipFuncSetAttribute((const void*)fwd_megakernel, hipFuncAttributeMaxDynamicSharedMemorySize, LDS_BYTES) != hipSuccess) { fprintf(stderr, "kernel_launch: hipFuncSetAttribute failed\n"); grid = -1; return; }
        if (hipOccupancyMaxActiveBlocksPerMultiprocessor(&per_cu, (const void*)fwd_megakernel, NTHREADS, LDS_BYTES) != hipSuccess || per_cu < 1) { fprintf(stderr, "kernel_launch: occupancy query gave %d\n", per_cu); per_cu = 1; }
        (void)hipGetLastError();
        grid = cus * per_cu;
    }
    if (grid < 0) return;
    Args a{};
    for (int i = 0; i < 23; ++i) a.in[i] = d_in[i];
    a.out = (float*)d_out; a.ws = (unsigned char*)d_ws;
#if MULTI_LAUNCH
    for (int ph = 0; ph < NPHASES; ++ph) { a.ph_lo = ph; a.ph_hi = ph + 1; hipLaunchKernelGGL(fwd_megakernel, dim3(grid), dim3(NTHREADS), LDS_BYTES, stream, a); }
#else
    a.ph_lo = 0; a.ph_hi = NPHASES;
    if (hipMemsetAsync((unsigned char*)d_ws + WS_CTL, 0, CTL_BYTES, stream) != hipSuccess) { fprintf(stderr, "kernel_launch: memset of the barrier words failed\n"); return; }
    void* args[] = {&a};
    hipError_t e = hipLaunchCooperativeKernel((const void*)fwd_megakernel, dim3(grid), dim3(NTHREADS), args, LDS_BYTES, stream);
    if (e != hipSuccess) fprintf(stderr, "cooperative launch failed: %s (grid %d)\n", hipGetErrorString(e), grid);
#endif
}
```

```cpp
#include <hip/hip_runtime.h>
#include <hip/hip_cooperative_groups.h>
#include <cstdio>
#include <cstdint>
namespace cg = cooperative_groups;
namespace pg8 {
#define PG8_LAS __attribute__((address_space(3)))
typedef unsigned short bf16_t;
typedef short bf16x8 __attribute__((ext_vector_type(8)));
typedef float f32x4 __attribute__((ext_vector_type(4)));
typedef unsigned u32x4 __attribute__((ext_vector_type(4)));
constexpr int BM = 256, BK = 64, HALF = 128, HTB = HALF * BK * 2  , STAGE_BYTES = 8 * HTB, NXCD = 8, WGM = 8;

__host__ __device__ __forceinline__ int lds_byte(int r, int c) { const int st = (r >> 4) * 2 + (c >> 5), rr = r & 15, cc = c & 31, ob = rr * 64 + cc * 2; return st * 1024 + (ob ^ (((ob >> 9) & 1) << 5)); }
__host__ __device__ __forceinline__ void stage_rc(int b, int& R, int& C) { const int st = b / 1024, sb = b % 1024, swz = sb ^ (((sb >> 9) & 1) << 5); R = (st >> 1) * 16 + swz / 64; C = (st & 1) * 32 + (swz % 64) / 2; }
__host__ __device__ __forceinline__ int perm32(int rho) { const int n = rho >> 4, i = rho & 15; return 8 * (i >> 2) + 4 * n + (i & 3); }

struct Unit { int pm, pn; };
struct Gemm { const bf16_t* A; const bf16_t* Bt; int M, N, K; };

struct StaticOrder {
    int nM, nN, nwg, G, c;
    __host__ __device__ void init(int M, int N, int G_, int c_) { nM = M / BM; nN = N / BM; nwg = nM * nN; G = G_; c = c_; }
    __host__ __device__ bool next(int i, Unit& u) const {
        const long L = (long)i * G + c; if (L >= nwg) return false;
        int wgid = (int)L; { const int q = nwg / NXCD, r = nwg % NXCD, xcd = wgid % NXCD, off = wgid / NXCD; wgid = (xcd < r ? xcd * (q + 1) : r * (q + 1) + (xcd - r) * q) + off; }
        const int nig = WGM * nN, gid = wgid / nig, fm = gid * WGM, gsz = (nM - fm) < WGM ? (nM - fm) : WGM;
        u.pm = fm + ((wgid % nig) % gsz); u.pn = (wgid % nig) / gsz; return true;
    }
    __device__ __forceinline__ void a_ready(const Unit&) const {}
    __device__ __forceinline__ void done(const Unit&) const {}
};

__device__ __forceinline__ unsigned cvt_pk_bf16(float lo, float hi) { unsigned r; asm volatile("v_cvt_pk_bf16_f32 %0, %1, %2" : "=v"(r) : "v"(lo), "v"(hi)); return r; }
typedef float f32x2 __attribute__((ext_vector_type(2)));
template <class Epi, class Sched, bool ALIGN_EPI = false, bool SP2 = false>
__device__ __forceinline__ void gemm_phase(PG8_LAS unsigned char* lds, const Gemm g, const Sched& S, const Epi& E) {
    const int tid = threadIdx.x, wid = __builtin_amdgcn_readfirstlane(tid >> 6), lane = tid & 63, wr = wid >> 2, wc = wid & 3, fr = lane & 15, fq = lane >> 4;
    const int K = g.K, nt = K / BK;
    unsigned voffA[2], voffB[2];
#pragma unroll
    for (int i = 0; i < 2; ++i) { int R, C; stage_rc(tid * 16 + i * 8192, R, C); const int Rb = Epi::PERM ? ((R & ~31) + perm32(R & 31)) : R;
        voffA[i] = (unsigned)(R * K + C) * 2u; voffB[i] = (unsigned)(Rb * K + C) * 2u; }
    const size_t kstep = (size_t)(BK * 2);
    const size_t hstep = (size_t)HALF * K * 2;
    const size_t tstep = 2 * hstep;
    const unsigned ldsw = (unsigned)wid * 1024u;
    const int aoff = lds_byte(wr * 64 + fr, fq * 8), boff = lds_byte(wc * 32 + fr, fq * 8);
#define PG8_SA(b, h) (((b) * 2 + (h)) * HTB)
#define PG8_SB(b, h) ((4 + (b) * 2 + (h)) * HTB)
#define PG8_STAGE(bufoff, gbase, voff) do { _Pragma("unroll") for (int _i = 0; _i < 2; ++_i) \
        __builtin_amdgcn_global_load_lds((const unsigned*)((const char*)(gbase) + (voff)[_i]), (PG8_LAS unsigned*)(lds + (bufoff) + ldsw + _i * 8192), 16, 0, 0); } while (0)
#define PG8_LDA(dst, b, h) do { _Pragma("unroll") for (int m = 0; m < 4; ++m) _Pragma("unroll") for (int k = 0; k < 2; ++k) dst[m][k] = *(const PG8_LAS bf16x8*)(lds + PG8_SA(b, h) + aoff + m * 2048 + k * 1024); } while (0)
#define PG8_LDB(dst, b, h) do { _Pragma("unroll") for (int n = 0; n < 2; ++n) _Pragma("unroll") for (int k = 0; k < 2; ++k) dst[n][k] = *(const PG8_LAS bf16x8*)(lds + PG8_SB(b, h) + boff + n * 2048 + k * 1024); } while (0)
#define PG8_MMA(ai, bj, At, Bt) do { __builtin_amdgcn_s_setprio(1); _Pragma("unroll") for (int m = 0; m < 4; ++m) _Pragma("unroll") for (int n = 0; n < 2; ++n) _Pragma("unroll") for (int k = 0; k < 2; ++k) \
        acc[ai][bj][m][n] = __builtin_amdgcn_mfma_f32_16x16x32_bf16(Bt[n][k], At[m][k], acc[ai][bj][m][n], 0, 0, 0); __builtin_amdgcn_s_setprio(0); } while (0)
#define PG8_WAIT_V(n) asm volatile("s_waitcnt vmcnt(" #n ")" ::: "memory")
#define PG8_WAIT_L(n) asm volatile("s_waitcnt lgkmcnt(" #n ")" ::: "memory")
#define PG8_BAR __builtin_amdgcn_s_barrier()
#define PG8_SCHED __builtin_amdgcn_sched_barrier(0)
    Unit cur, nxt; int ui = 0;
    if (!S.next(0, cur)) return;
    f32x4 acc[2][2][4][2];
#pragma unroll
    for (int a = 0; a < 2; ++a)
#pragma unroll
        for (int b = 0; b < 2; ++b)
#pragma unroll
            for (int m = 0; m < 4; ++m)
#pragma unroll
                for (int n = 0; n < 2; ++n) acc[a][b][m][n] = (f32x4){0.f, 0.f, 0.f, 0.f};
    bf16x8 At[4][2], B0[2][2], B1[2][2];
    const char* cA = (const char*)g.A + (size_t)cur.pm * tstep; const char* cB = (const char*)g.Bt + (size_t)cur.pn * tstep;
    S.a_ready(cur);
    if constexpr (SP2) {
        PG8_STAGE(PG8_SB(0, 0), cB, voffB); PG8_STAGE(PG8_SB(0, 1), cB + hstep, voffB); PG8_STAGE(PG8_SA(0, 0), cA, voffA); PG8_STAGE(PG8_SA(0, 1), cA + hstep, voffA);
        if (wr == 1) PG8_BAR;
        PG8_WAIT_V(2); PG8_BAR;
        PG8_STAGE(PG8_SB(1, 0), cB + kstep, voffB); PG8_STAGE(PG8_SA(1, 0), cA + kstep, voffA); PG8_STAGE(PG8_SB(1, 1), cB + hstep + kstep, voffB);
        PG8_WAIT_V(6); PG8_BAR;
    } else {
        PG8_STAGE(PG8_SB(0, 0), cB, voffB); PG8_STAGE(PG8_SA(0, 0), cA, voffA); PG8_STAGE(PG8_SB(0, 1), cB + hstep, voffB); PG8_STAGE(PG8_SA(0, 1), cA + hstep, voffA);
        if (wr == 1) PG8_BAR;
        PG8_WAIT_V(4); PG8_BAR;
        PG8_STAGE(PG8_SB(1, 0), cB + kstep, voffB); PG8_STAGE(PG8_SA(1, 0), cA + kstep, voffA); PG8_STAGE(PG8_SB(1, 1), cB + hstep + kstep, voffB);
        PG8_WAIT_V(6); PG8_BAR;
    }
    for (;;) {
        const bool has_next = S.next(ui + 1, nxt);
        const char* nA = has_next ? (const char*)g.A + (size_t)nxt.pm * tstep : cA; const char* nB = has_next ? (const char*)g.Bt + (size_t)nxt.pn * tstep : cB;
        for (int t = 0; t < nt; t += 2) {
            const bool last = (t == nt - 2);
            const char* a1 = cA + (size_t)(t + 1) * kstep;
            const char* a2 = last ? nA : cA + (size_t)(t + 2) * kstep; const char* b2 = last ? nB : cB + (size_t)(t + 2) * kstep;
            const char* a3 = a2 + kstep; const char* b3 = b2 + kstep;
            if (last && has_next) S.a_ready(nxt);
            if constexpr (SP2) {
            PG8_LDB(B0, 0, 0); PG8_LDB(B1, 0, 1); PG8_SCHED; PG8_LDA(At, 0, 0); PG8_STAGE(PG8_SA(1, 1), a1 + hstep, voffA);
            PG8_WAIT_V(8); PG8_WAIT_L(0); PG8_BAR; PG8_MMA(0, 0, At, B0); PG8_MMA(0, 1, At, B1); PG8_BAR; PG8_SCHED;
            PG8_LDA(At, 0, 1); PG8_STAGE(PG8_SB(0, 0), b2, voffB); PG8_STAGE(PG8_SB(0, 1), b2 + hstep, voffB); PG8_STAGE(PG8_SA(0, 0), a2, voffA);
            PG8_WAIT_V(8); PG8_WAIT_L(0); PG8_BAR; PG8_MMA(1, 0, At, B0); PG8_MMA(1, 1, At, B1); PG8_BAR; PG8_SCHED;
            PG8_LDB(B0, 1, 0); PG8_LDB(B1, 1, 1); PG8_SCHED; PG8_LDA(At, 1, 0); PG8_STAGE(PG8_SA(0, 1), a2 + hstep, voffA);
            PG8_WAIT_V(8); PG8_WAIT_L(0); PG8_BAR; PG8_MMA(0, 0, At, B0); PG8_MMA(0, 1, At, B1); PG8_BAR; PG8_SCHED;
            PG8_LDA(At, 1, 1); PG8_STAGE(PG8_SB(1, 0), b3, voffB); PG8_STAGE(PG8_SB(1, 1), b3 + hstep, voffB); PG8_STAGE(PG8_SA(1, 0), a3, voffA);
            PG8_WAIT_V(8); PG8_WAIT_L(0); PG8_BAR; PG8_MMA(1, 0, At, B0); PG8_MMA(1, 1, At, B1); PG8_BAR; PG8_SCHED;
            } else {
            PG8_LDB(B0, 0, 0); PG8_SCHED; PG8_LDA(At, 0, 0); PG8_STAGE(PG8_SA(1, 1), a1 + hstep, voffA);
            PG8_WAIT_L(8); PG8_BAR; PG8_WAIT_L(0); PG8_MMA(0, 0, At, B0); PG8_BAR; PG8_SCHED;
            PG8_LDB(B1, 0, 1); PG8_STAGE(PG8_SB(0, 0), b2, voffB);
            PG8_BAR; PG8_WAIT_L(0); PG8_MMA(0, 1, At, B1); PG8_BAR;
            PG8_LDA(At, 0, 1); PG8_STAGE(PG8_SA(0, 0), a2, voffA);
            PG8_BAR; PG8_WAIT_L(0); PG8_MMA(1, 0, At, B0); PG8_BAR; PG8_SCHED;
            PG8_STAGE(PG8_SB(0, 1), b2 + hstep, voffB);
            PG8_WAIT_V(6); PG8_BAR; PG8_MMA(1, 1, At, B1); PG8_BAR;
            PG8_LDB(B0, 1, 0); PG8_SCHED; PG8_LDA(At, 1, 0); PG8_STAGE(PG8_SA(0, 1), a2 + hstep, voffA);
            PG8_WAIT_L(8); PG8_BAR; PG8_WAIT_L(0); PG8_MMA(0, 0, At, B0); PG8_BAR; PG8_SCHED;
            PG8_LDB(B1, 1, 1); PG8_STAGE(PG8_SB(1, 0), b3, voffB);
            PG8_BAR; PG8_WAIT_L(0); PG8_MMA(0, 1, At, B1); PG8_BAR;
            PG8_LDA(At, 1, 1); PG8_STAGE(PG8_SA(1, 0), a3, voffA);
            PG8_BAR; PG8_WAIT_L(0); PG8_MMA(1, 0, At, B0); PG8_BAR; PG8_SCHED;
            PG8_STAGE(PG8_SB(1, 1), b3 + hstep, voffB);
            PG8_WAIT_V(6); PG8_BAR; PG8_MMA(1, 1, At, B1); PG8_BAR;
            }
        }
        if constexpr (ALIGN_EPI) { if (wr == 0) PG8_BAR; }
        if constexpr (!Epi::AFTER_DRAIN) { E(acc, cur, wr, wc, fr, fq); S.done(cur); }
        if (!has_next) break;
#pragma unroll
        for (int a = 0; a < 2; ++a)
#pragma unroll
            for (int b = 0; b < 2; ++b)
#pragma unroll
                for (int m = 0; m < 4; ++m)
#pragma unroll
                    for (int n = 0; n < 2; ++n) acc[a][b][m][n] = (f32x4){0.f, 0.f, 0.f, 0.f};
        cur = nxt; cA = nA; cB = nB; ++ui;
        if constexpr (ALIGN_EPI) { if (wr == 1) PG8_BAR; }
    }
    PG8_WAIT_V(0);
    if constexpr (!ALIGN_EPI) { if (wr == 0) PG8_BAR; }
    PG8_BAR;
    if constexpr (Epi::AFTER_DRAIN) { E.fused(acc, cur, wr, wc, fr, fq, lds, wid, lane); S.done(cur); }
#undef PG8_SA
#undef PG8_SB
#undef PG8_STAGE
#undef PG8_LDA
#undef PG8_LDB
#undef PG8_MMA
#undef PG8_WAIT_V
#undef PG8_WAIT_L
#undef PG8_BAR
#undef PG8_SCHED
}
}

#define LAS __attribute__((address_space(3)))
typedef unsigned short bf16;
typedef short bf16x8 __attribute__((ext_vector_type(8)));
typedef short s16x4 __attribute__((ext_vector_type(4)));
typedef float f32x4 __attribute__((ext_vector_type(4)));
typedef unsigned u32x4 __attribute__((ext_vector_type(4)));
typedef unsigned u32x2 __attribute__((ext_vector_type(2)));
using pg8::cvt_pk_bf16;

#ifndef MULTI_LAUNCH
#define MULTI_LAUNCH 0
#endif

constexpr int S = 8192, D = 2048, FF = 5632, NGU = 2 * FF, NCONV = 5120, NNSA = 2304, NNSA_SRC = 2084, NKV = 3072, CONVC = 1536;
constexpr int NMEM = 256, MEMKVW = 1024, QW = 1536;
constexpr int NTHREADS = 512, NWAVES = 8, LDS_BYTES = 131072 + 2048 + 256;
constexpr int NPHASES = 22;

constexpr size_t al256(size_t x) { return (x + 255) & ~(size_t)255; }
constexpr size_t SZ_WGU = (size_t)NGU * D * 2, SZ_WD = (size_t)D * FF * 2;
constexpr size_t WS_WGU = 0;
constexpr size_t WS_WD = WS_WGU + 4 * SZ_WGU;
constexpr size_t WS_WCONV = WS_WD + 4 * SZ_WD;
constexpr size_t WS_WNSA = WS_WCONV + (size_t)NCONV * D * 2;
constexpr size_t WS_WOUT = WS_WNSA + (size_t)NNSA * D * 2;
constexpr size_t WS_WKV = WS_WOUT + 2 * (size_t)D * D * 2;
constexpr size_t WS_WMEM = WS_WKV + (size_t)NKV * D * 2;
constexpr size_t WS_W1C = WS_WMEM + 2 * (size_t)MEMKVW * D * 2;
constexpr size_t WS_W2C = WS_W1C + 2 * (size_t)128 * 4096 * 2;
constexpr size_t WS_H = WS_W2C + 2 * (size_t)128 * 128 * 2;
constexpr size_t WS_XN = WS_H + (size_t)S * D * 4;
constexpr size_t WS_XKV = WS_XN + (size_t)S * D * 2;
constexpr size_t WS_ACT = WS_XKV + (size_t)S * D * 2;
constexpr size_t WS_UCONV = WS_ACT;
constexpr size_t WS_UNSA = WS_ACT;
constexpr size_t WS_TMP = WS_ACT + (size_t)S * NNSA * 2;
constexpr size_t WS_UKV = WS_ACT + (size_t)S * FF * 2;
constexpr size_t WS_CAT = WS_UKV + (size_t)S * NKV * 2;
constexpr size_t WS_KCR = WS_CAT + (size_t)S * D * 2;
constexpr size_t SZ_KR = (size_t)4 * S * 128 * 2, SLACK = 16 * 128 * 2;
constexpr size_t WS_VCR = WS_KCR + SZ_KR + SLACK;
constexpr size_t WS_KSR = WS_VCR + SZ_KR + SLACK;
constexpr size_t WS_KWR = WS_KSR + SZ_KR;
constexpr size_t WS_KCC = WS_KWR + SZ_KR;
constexpr size_t WS_VCC = WS_KCC + (size_t)4 * 512 * 128 * 2;
constexpr size_t WS_MEMN = WS_VCC + (size_t)4 * 512 * 128 * 2;
constexpr size_t WS_MEMKV = WS_MEMN + 2 * (size_t)NMEM * D * 2;
constexpr size_t WS_ROPE = WS_MEMKV + 2 * (size_t)NMEM * MEMKVW * 2;
constexpr size_t WS_SELB = WS_ROPE + (size_t)S * 32 * 4;
constexpr size_t WS_SS = WS_SELB + (size_t)S * 4 * 4 * 4;
constexpr size_t WS_CTL = WS_SS + (size_t)5 * S * 4;
constexpr size_t CTL_BYTES = 16384;
constexpr size_t WS_END = WS_CTL + CTL_BYTES;
static_assert((size_t)S * NNSA * 2 + (size_t)S * QW * 4 <= (size_t)S * FF * 2, "overlay fits in ACT");
static_assert((size_t)S * NCONV * 2 <= (size_t)S * FF * 2, "overlay fits in ACT");
static_assert(WS_END <= (size_t)4 * 2 * 2 * 2048 * 5632 * 4, "workspace must fit the guaranteed size");

struct Args { const void* in[23]; float* out; unsigned char* ws; int ph_lo, ph_hi; };

struct Ctx { LAS unsigned char* lds; int tid, lane, wid, G, bid; };

__device__ __forceinline__ float bf2f(unsigned short b) { return __uint_as_float(((unsigned)b) << 16); }
__device__ __forceinline__ float bflo(unsigned w) { return __uint_as_float(w << 16); }
__device__ __forceinline__ float bfhi(unsigned w) { return __uint_as_float(w & 0xffff0000u); }
__device__ __forceinline__ float wave_sum(float v) {
#pragma unroll
    for (int o = 1; o < 64; o <<= 1) v += __shfl_xor(v, o);
    return v;
}
__device__ __forceinline__ float fexp2(float x) { return __builtin_amdgcn_exp2f(x); }

__device__ __forceinline__ float rstd_of(const float* ss, int row) { return ss ? 1.0f / sqrtf(ss[row] * (1.0f / D) + 1e-6f) : 1.0f; }
struct EpiPlain {
    static constexpr bool PERM = true, AFTER_DRAIN = false;
    bf16* O; int ldc; const float* ss = nullptr;
    __device__ __forceinline__ void operator()(const f32x4 (&acc)[2][2][4][2], const pg8::Unit& u, int wr, int wc, int fr, int fq) const {
        const int row0 = u.pm * 256 + wr * 64 + fr, col0 = u.pn * 256 + wc * 32 + 8 * fq;
#pragma unroll
        for (int ai = 0; ai < 2; ++ai)
#pragma unroll
            for (int m = 0; m < 4; ++m) { const int row = row0 + ai * 128 + m * 16; bf16* rowp = O + (size_t)row * ldc + col0; const float rs = rstd_of(ss, row);
#pragma unroll
                for (int bj = 0; bj < 2; ++bj) { const f32x4 v0 = acc[ai][bj][m][0] * rs, v1 = acc[ai][bj][m][1] * rs;
                    u32x4 w; w.x = cvt_pk_bf16(v0[0], v0[1]); w.y = cvt_pk_bf16(v0[2], v0[3]); w.z = cvt_pk_bf16(v1[0], v1[1]); w.w = cvt_pk_bf16(v1[2], v1[3]);
                    *(u32x4*)(rowp + bj * 128) = w; } }
    }
};
__device__ __forceinline__ float silu_mul(float g, float u) { return g * __builtin_amdgcn_rcpf(1.0f + fexp2(-1.4426950408889634f * g)) * u; }
struct EpiSwiGLU {
    static constexpr bool PERM = true, AFTER_DRAIN = false;
    bf16* O; int ldc; const float* ss = nullptr;
    __device__ __forceinline__ void operator()(const f32x4 (&acc)[2][2][4][2], const pg8::Unit& u, int wr, int wc, int fr, int fq) const {
        const int row0 = u.pm * 256 + wr * 64 + fr, col0 = u.pn * 128 + wc * 32 + 8 * fq;
#pragma unroll
        for (int ai = 0; ai < 2; ++ai)
#pragma unroll
            for (int m = 0; m < 4; ++m) { const int row = row0 + ai * 128 + m * 16; bf16* rowp = O + (size_t)row * ldc + col0; const float rs = rstd_of(ss, row);
                const f32x4 g0 = acc[ai][0][m][0] * rs, g1 = acc[ai][0][m][1] * rs, u0 = acc[ai][1][m][0] * rs, u1 = acc[ai][1][m][1] * rs;
                u32x4 w;
                w.x = cvt_pk_bf16(silu_mul(g0[0], u0[0]), silu_mul(g0[1], u0[1])); w.y = cvt_pk_bf16(silu_mul(g0[2], u0[2]), silu_mul(g0[3], u0[3]));
                w.z = cvt_pk_bf16(silu_mul(g1[0], u1[0]), silu_mul(g1[1], u1[1])); w.w = cvt_pk_bf16(silu_mul(g1[2], u1[2]), silu_mul(g1[3], u1[3]));
                *(u32x4*)rowp = w; }
    }
};
struct EpiRes {
    static constexpr bool PERM = true, AFTER_DRAIN = false;
    const float* base; float* out; int ldc; float alpha;
    float* ss = nullptr; bf16* o1 = nullptr;
    __device__ __forceinline__ void operator()(const f32x4 (&acc)[2][2][4][2], const pg8::Unit& u, int wr, int wc, int fr, int fq) const {
        const int row0 = u.pm * 256 + wr * 64 + fr, col0 = u.pn * 256 + wc * 32 + 8 * fq;
#pragma unroll
        for (int ai = 0; ai < 2; ++ai)
#pragma unroll
            for (int m = 0; m < 4; ++m) { const int row = row0 + ai * 128 + m * 16; const size_t off = (size_t)row * ldc + col0; float sq = 0.f;
#pragma unroll
                for (int bj = 0; bj < 2; ++bj) { const int co = bj * 128;
                    const f32x4 b0 = *(const f32x4*)(base + off + co), b1 = *(const f32x4*)(base + off + co + 4);
                    const f32x4 v0 = b0 + alpha * acc[ai][bj][m][0], v1 = b1 + alpha * acc[ai][bj][m][1];
                    *(f32x4*)(out + off + co) = v0; *(f32x4*)(out + off + co + 4) = v1;
                    if (ss) { sq += ((v0.x * v0.x + v0.y * v0.y) + (v0.z * v0.z + v0.w * v0.w)) + ((v1.x * v1.x + v1.y * v1.y) + (v1.z * v1.z + v1.w * v1.w));
                        u32x4 w; w.x = cvt_pk_bf16(v0.x, v0.y); w.y = cvt_pk_bf16(v0.z, v0.w); w.z = cvt_pk_bf16(v1.x, v1.y); w.w = cvt_pk_bf16(v1.z, v1.w); *(u32x4*)(o1 + off + co) = w; } }
                if (ss) { sq += __shfl_xor(sq, 16); sq += __shfl_xor(sq, 32); if (fq == 0) atomicAdd(ss + row, sq); } }
    }
};

template <class Epi>
__device__ __forceinline__ void run_gemm(const Ctx& c, const bf16* A, const bf16* Bt, int M, int N, int K, const Epi& E, int cidx) {
    pg8::Gemm g{A, Bt, M, N, K}; pg8::StaticOrder So; So.init(M, N, c.G, cidx);
    pg8::gemm_phase<Epi, pg8::StaticOrder, true, true>(c.lds, g, So, E);
}

struct Seg { const float* src; bf16* dst; int K, N, c0, nc, d0, mode; const float* gk; };
constexpr int NSEG = 25;
__device__ __forceinline__ Seg get_seg(const Args& a, int id) {
    Seg s; unsigned char* ws = a.ws; s.c0 = 0; s.d0 = 0; s.mode = 0; s.gk = nullptr;
    if (id < 12) { const int f = id / 3, kind = id - 3 * f;
        if (kind == 0) { s.src = (const float*)a.in[4] + (size_t)f * D * FF; s.dst = (bf16*)(ws + WS_WGU + f * SZ_WGU); s.K = D; s.N = FF; s.nc = FF; s.mode = 1; if (f > 0) s.gk = (const float*)a.in[3] + (size_t)f * D; }
        else if (kind == 1) { s.src = (const float*)a.in[5] + (size_t)f * D * FF; s.dst = (bf16*)(ws + WS_WGU + f * SZ_WGU); s.K = D; s.N = FF; s.nc = FF; s.mode = 1; s.d0 = 128; if (f > 0) s.gk = (const float*)a.in[3] + (size_t)f * D; }
        else { s.src = (const float*)a.in[6] + (size_t)f * FF * D; s.dst = (bf16*)(ws + WS_WD + f * SZ_WD); s.K = FF; s.N = D; s.nc = D; }
    } else if (id == 12) { s.src = (const float*)a.in[11]; s.dst = (bf16*)(ws + WS_WCONV); s.K = D; s.N = NCONV; s.nc = NCONV; s.gk = (const float*)a.in[7]; }
    else if (id == 13) { s.src = (const float*)a.in[13]; s.dst = (bf16*)(ws + WS_WNSA); s.K = D; s.N = NNSA_SRC; s.c0 = 0; s.nc = 1536; s.d0 = 0; s.gk = (const float*)a.in[7] + D; }
    else if (id == 14) { s.src = (const float*)a.in[13]; s.dst = (bf16*)(ws + WS_WNSA); s.K = D; s.N = NNSA_SRC; s.c0 = 1536; s.nc = 36; s.d0 = 2048; s.gk = (const float*)a.in[7] + D; }
    else if (id == 15) { s.src = (const float*)a.in[13]; s.dst = (bf16*)(ws + WS_WNSA); s.K = D; s.N = NNSA_SRC; s.c0 = 1572; s.nc = 512; s.d0 = 1536; s.gk = (const float*)a.in[7] + D; }
    else if (id <= 17) { const int l = id - 16; s.src = (const float*)a.in[10] + (size_t)l * D * D; s.dst = (bf16*)(ws + WS_WOUT + (size_t)l * D * D * 2); s.K = D; s.N = D; s.nc = D; }
    else if (id == 18) { s.src = (const float*)a.in[15]; s.dst = (bf16*)(ws + WS_WKV); s.K = D; s.N = NKV; s.nc = NKV; s.gk = (const float*)a.in[14]; }
    else if (id <= 20) { const int l = id - 19; s.src = (const float*)a.in[9] + (size_t)l * D * MEMKVW; s.dst = (bf16*)(ws + WS_WMEM + (size_t)l * MEMKVW * D * 2); s.K = D; s.N = MEMKVW; s.nc = MEMKVW; }
    else if (id <= 22) { const int w = id - 21; s.src = (const float*)a.in[w ? 20 : 17]; s.dst = (bf16*)(ws + WS_W1C + (size_t)w * 128 * 4096 * 2); s.K = 4096; s.N = 128; s.nc = 128; }
    else { const int w = id - 23; s.src = (const float*)a.in[w ? 21 : 18]; s.dst = (bf16*)(ws + WS_W2C + (size_t)w * 128 * 128 * 2); s.K = 128; s.N = 128; s.nc = 128; }
    return s;
}
__device__ __forceinline__ void transpose_item(const Seg& s, LAS float* scr, int item, int lane) {
    const int nblk = (s.nc + 31) >> 5, kb = item / nblk, nb = item - kb * nblk, k0 = 64 * kb, cb = 32 * nb;
    const int cl = cb + (lane & 31); const bool cok = cl < s.nc;
    const float* sp = s.src + (size_t)(k0 + (lane >> 5)) * s.N + s.c0 + cl;
    float tv[32];
#pragma unroll
    for (int i = 0; i < 32; ++i) tv[i] = cok ? __builtin_nontemporal_load(sp + (size_t)(2 * i) * s.N) : 0.f;
    if (s.gk) {
#pragma unroll
        for (int i = 0; i < 32; ++i) tv[i] *= s.gk[k0 + 2 * i + (lane >> 5)];
    }
#pragma unroll
    for (int i = 0; i < 32; ++i) scr[(2 * i + (lane >> 5)) * 33 + (lane & 31)] = tv[i];
    asm volatile("s_waitcnt lgkmcnt(0)" ::: "memory");
    const int c8 = lane & 7;
#pragma unroll
    for (int j = 0; j < 4; ++j) { const int n = (lane >> 3) + 8 * j; const int c = cb + n; const LAS float* q = scr + (8 * c8) * 33 + n;
        u32x4 o; o.x = cvt_pk_bf16(q[0 * 33], q[1 * 33]); o.y = cvt_pk_bf16(q[2 * 33], q[3 * 33]); o.z = cvt_pk_bf16(q[4 * 33], q[5 * 33]); o.w = cvt_pk_bf16(q[6 * 33], q[7 * 33]);
        const int drow = s.d0 + (s.mode ? ((c >> 7) * 256 + (c & 127)) : c);
        if (c < s.nc) *(u32x4*)(s.dst + (size_t)drow * s.K + k0 + 8 * c8) = o; }
    asm volatile("s_waitcnt lgkmcnt(0)" ::: "memory");
}

__device__ __forceinline__ void rms_row(const float* xrow, const float* g1, bf16* o1, const float* g2, bf16* o2, float* of, int lane) {
    const f32x4* xr = (const f32x4*)xrow + lane;
    f32x4 v[8]; float s = 0.f;
#pragma unroll
    for (int j = 0; j < 8; ++j) { v[j] = xr[64 * j]; s += (v[j].x * v[j].x + v[j].y * v[j].y) + (v[j].z * v[j].z + v[j].w * v[j].w); }
    const float rstd = 1.0f / sqrtf(wave_sum(s) * (1.0f / D) + 1e-6f);
#pragma unroll
    for (int j = 0; j < 8; ++j) { const f32x4 y = v[j] * rstd; const f32x4 ga = ((const f32x4*)g1)[lane + 64 * j]; const f32x4 a = y * ga;
        if (o1) { u32x2 w; w.x = cvt_pk_bf16(a.x, a.y); w.y = cvt_pk_bf16(a.z, a.w); ((u32x2*)o1)[lane + 64 * j] = w; }
        if (of) ((f32x4*)of)[lane + 64 * j] = a;
        if (o2) { const f32x4 gb = ((const f32x4*)g2)[lane + 64 * j]; const f32x4 b = y * gb; u32x2 w; w.x = cvt_pk_bf16(b.x, b.y); w.y = cvt_pk_bf16(b.z, b.w); ((u32x2*)o2)[lane + 64 * j] = w; } }
}
__device__ __forceinline__ void norm_rows(const Ctx& c, const float* src, int nrows, const float* g1, bf16* o1, const float* g2, bf16* o2, float* of) {
    const int gw = c.bid * NWAVES + c.wid, NGW = c.G * NWAVES;
    for (int r = gw; r < nrows; r += NGW) rms_row(src + (size_t)r * D, g1, o1 ? o1 + (size_t)r * D : nullptr, g2, o2 ? o2 + (size_t)r * D : nullptr, of ? of + (size_t)r * D : nullptr, c.lane);
}

__device__ __forceinline__ void convert_segs(const Ctx& c, const Args& a, unsigned mask, int widx, int nwork) {
    LAS float* scr = (LAS float*)(c.lds + c.wid * 16384);
    const int gw = widx * NWAVES + c.wid, NGW = nwork * NWAVES;
    int base = 0;
    for (int sid = 0; sid < NSEG; ++sid) {
        if (!((mask >> sid) & 1u)) continue;
        const Seg s = get_seg(a, sid);
        const int n = (s.K >> 6) * ((s.nc + 31) >> 5);
        int first = (gw - base) % NGW; if (first < 0) first += NGW;
        for (int it = first; it < n; it += NGW) transpose_item(s, scr, it, c.lane);
        base = (base + n) % NGW;
    }
}
constexpr unsigned SEGM(int i) { return 1u << i; }
constexpr unsigned CV_ALL = (1u << NSEG) - 1u;
constexpr unsigned CV_P1 = SEGM(2) | SEGM(12);
constexpr unsigned CV_P4 = SEGM(16) | SEGM(3) | SEGM(4);
constexpr unsigned CV_P8 = SEGM(5) | SEGM(13) | SEGM(14) | SEGM(15) | SEGM(21) | SEGM(22) | SEGM(23) | SEGM(24) | SEGM(17);
constexpr unsigned CV_P14 = SEGM(9) | SEGM(10);
constexpr unsigned CV_P19 = SEGM(11);
constexpr unsigned CV_P0 = CV_ALL & ~(CV_P1 | CV_P4 | CV_P8 | CV_P14 | CV_P19);
__device__ __forceinline__ void prologue(const Ctx& c, const Args& a) {
    convert_segs(c, a, (c.G == 256) ? CV_P0 : CV_ALL, c.bid, c.G);
    const int gw = c.bid * NWAVES + c.wid, NGW = c.G * NWAVES;
    norm_rows(c, (const float*)a.in[0], S, (const float*)a.in[3], (bf16*)(a.ws + WS_XN), nullptr, nullptr, nullptr);
    norm_rows(c, (const float*)a.in[1], NMEM, (const float*)a.in[8], (bf16*)(a.ws + WS_MEMN), (const float*)a.in[8] + D, (bf16*)(a.ws + WS_MEMN + (size_t)NMEM * D * 2), nullptr);
    const int* pos = (const int*)a.in[2]; float* rope = (float*)(a.ws + WS_ROPE);
    for (int i = c.bid * NTHREADS + c.tid; i < S * 16; i += c.G * NTHREADS) { const int t = i >> 4, f = i & 15;
        const double inv = pow(500000.0, -(double)f / 16.0);
        const double ang = (double)pos[t] * inv; rope[t * 32 + f] = (float)cos(ang); rope[t * 32 + 16 + f] = (float)sin(ang); }
    for (int i = c.bid * NTHREADS + c.tid; i < 5 * S; i += c.G * NTHREADS) ((float*)(a.ws + WS_SS))[i] = 0.f;
    for (int i = c.bid * NTHREADS + c.tid; i < 2 * 2048; i += c.G * NTHREADS) { bf16* p = (bf16*)(a.ws + (i < 2048 ? WS_KCR : WS_VCR) + SZ_KR); p[i & 2047] = 0; }
}

typedef short v4i16_t __attribute__((ext_vector_type(4)));
__device__ __forceinline__ s16x4 vtr(LAS const unsigned char* p) { return __builtin_bit_cast(s16x4, __builtin_amdgcn_ds_read_tr16_b64_v4i16((LAS v4i16_t*)p)); }
__device__ __forceinline__ unsigned xr_of(unsigned row) { return ((row & 3u) << 2) | ((row >> 2) & 3u); }
constexpr int KV_BUF = 32768;
constexpr int IMP_OFF = 65536;
constexpr float C1 = 0.08838834764831845f * 1.4426950408889634f;

__device__ __forceinline__ void stage_kv(LAS unsigned char* buf, const bf16* Kg, int ldk, const bf16* Vg, int ldv, int key0, int wid, int lane_in) {
    int lane = lane_in; asm volatile("" : "+v"(lane));
#pragma unroll
    for (int i = 0; i < 2; ++i) {
        const unsigned b = (unsigned)(i * 8192 + wid * 1024 + lane * 16); const unsigned row = b >> 8, pos = (b >> 4) & 15u; const unsigned ch = pos ^ xr_of(row);
        const unsigned chv = pos ^ (2u * (row & 7u));
        __builtin_amdgcn_global_load_lds((const unsigned*)(Kg + (size_t)(key0 + (int)row) * ldk + ch * 8), (LAS unsigned*)(buf + i * 8192 + wid * 1024), 16, 0, 0);
        __builtin_amdgcn_global_load_lds((const unsigned*)(Vg + (size_t)(key0 + (int)row) * ldv + chv * 8), (LAS unsigned*)(buf + 16384 + i * 8192 + wid * 1024), 16, 0, 0);
    }
}

__device__ __forceinline__ float gmax4(float x) { auto a = __builtin_amdgcn_permlane16_swap(__float_as_uint(x), __float_as_uint(x), false, false); x = fmaxf(__uint_as_float(a[0]), __uint_as_float(a[1]));
    auto b = __builtin_amdgcn_permlane32_swap(__float_as_uint(x), __float_as_uint(x), false, false); return fmaxf(__uint_as_float(b[0]), __uint_as_float(b[1])); }
__device__ __forceinline__ float gsum4(float x) { auto a = __builtin_amdgcn_permlane16_swap(__float_as_uint(x), __float_as_uint(x), false, false); x = __uint_as_float(a[0]) + __uint_as_float(a[1]);
    auto b = __builtin_amdgcn_permlane32_swap(__float_as_uint(x), __float_as_uint(x), false, false); return __uint_as_float(b[0]) + __uint_as_float(b[1]); }
struct AX { float linv[3]; float tc; LAS float* impw; bool first; unsigned sel[4]; };

template <int NH, int MODE, bool EMASK, int QS>
__device__ __forceinline__ void attn_tile(LAS const unsigned char* kbuf, LAS const unsigned char* vbuf, const bf16x8 (&Q)[NH][4], f32x4 (&O)[NH][8], float (&m)[NH], float (&l)[NH],
                                          int key0, int T, int t, int lane_in, unsigned csel, AX& ax) {
    constexpr int HV = (NH > 1) ? 2 : 1, KBN = 4 / HV, CN = 2 / HV;
    int lane = lane_in; asm volatile("" : "+v"(lane));
    const int g = lane >> 4, r = lane & 15;
    const unsigned xr = xr_of((unsigned)r);
    const unsigned kbase = 256u * (unsigned)r + 16u * ((unsigned)g ^ (xr & 3u)), xs = xr >> 2;
    const unsigned q = (unsigned)r >> 2, pp = (unsigned)r & 3u;
    const unsigned wv = 4u * ((unsigned)g & 1u) + q;
    const unsigned vrow = 256u * (4u * (unsigned)g + q) + 8u * (pp & 1u) + 16u * (pp >> 1);
    const float NEG = -__builtin_inff();
    float prevc = ax.tc;
#pragma unroll
    for (int hf = 0; hf < HV; ++hf) {
        f32x4 sacc[NH][KBN];
#pragma unroll
        for (int h = 0; h < NH; ++h)
#pragma unroll
            for (int kbl = 0; kbl < KBN; ++kbl) sacc[h][kbl] = (f32x4){0.f, 0.f, 0.f, 0.f};
#pragma unroll
        for (int kbl = 0; kbl < KBN; ++kbl) {
            bf16x8 kf[4];
#pragma unroll
            for (int s = 0; s < 4; ++s) kf[s] = *(LAS const bf16x8*)(kbuf + kbase + 4096u * (hf * KBN + kbl) + 64u * ((unsigned)s ^ xs));
            __builtin_amdgcn_s_setprio(1);
#pragma unroll
            for (int s = 0; s < 4; ++s)
#pragma unroll
                for (int h = 0; h < NH; ++h) sacc[h][kbl] = __builtin_amdgcn_mfma_f32_16x16x32_bf16(kf[s], Q[h][s], sacc[h][kbl], 0, 0, 0);
            __builtin_amdgcn_s_setprio(0);
            if (NH > 1) __builtin_amdgcn_sched_barrier(0);
        }
        bf16x8 pk[NH][CN];
        float mainh[KBN], carh[KBN];
#pragma unroll
        for (int kbl = 0; kbl < KBN; ++kbl) { mainh[kbl] = 0.f; carh[kbl] = 0.f; }
#pragma unroll
        for (int h = 0; h < NH; ++h) {
            const int th = t + QS * h;
            int hi_lim = 1 << 20, lo_lim = -(1 << 20);
            if (MODE == 0 || MODE == 1) hi_lim = ((th - 31) >> 4) - key0 - 4 * g;
            if (MODE == 2 || MODE == 3) hi_lim = th - key0 - 4 * g;
            if (MODE == 3) lo_lim = th - 512 - key0 - 4 * g;
            const float bias = (MODE == 2 && !((csel >> h) & 1u)) ? NEG : 0.f;
            float x[KBN][4]; float mx = NEG;
#pragma unroll
            for (int kbl = 0; kbl < KBN; ++kbl)
#pragma unroll
                for (int i = 0; i < 4; ++i) {
                    float v = sacc[h][kbl][i];
                    if (EMASK) { const int e = 16 * (hf * KBN + kbl) + i; const bool valid = (MODE == 3) ? (e <= hi_lim && e > lo_lim) : (e <= hi_lim); v = valid ? v : NEG; }
                    x[kbl][i] = v; mx = fmaxf(mx, v);
                }
            float p[KBN][4];
            if (MODE == 1) {
                const float nmu = -m[h], li = ax.linv[h];
#pragma unroll
                for (int kbl = 0; kbl < KBN; ++kbl) {
#pragma unroll
                    for (int i = 0; i < 4; ++i) p[kbl][i] = fexp2(fmaf(x[kbl][i], C1, nmu)) * li;
                    mainh[kbl] += (p[kbl][0] + p[kbl][1]) + (p[kbl][2] + 0.5f * p[kbl][3]); carh[kbl] += 0.5f * p[kbl][3];
                }
            } else {
                mx = gmax4(mx);
                mx = mx * C1 + bias;
                const float mn = fmaxf(m[h], mx); const float mu = (mn == NEG) ? 0.f : mn;
                const float alpha = fexp2(m[h] - mu); const float nb_ = bias - mu;
                float ps = 0.f;
#pragma unroll
                for (int kbl = 0; kbl < KBN; ++kbl)
#pragma unroll
                    for (int i = 0; i < 4; ++i) { p[kbl][i] = fexp2(fmaf(x[kbl][i], C1, nb_)); ps += p[kbl][i]; }
                l[h] = l[h] * alpha + ps; m[h] = mn;
                if (MODE != 0) {
                    if (__ballot(alpha != 1.0f) != 0ull) {
#pragma unroll
                        for (int db = 0; db < 8; ++db) O[h][db] = O[h][db] * alpha;
                    }
                }
            }
            if (MODE != 0) {
#pragma unroll
                for (int cl = 0; cl < CN; ++cl) {
                    u32x4 w; w.x = cvt_pk_bf16(p[2 * cl][0], p[2 * cl][1]); w.y = cvt_pk_bf16(p[2 * cl][2], p[2 * cl][3]);
                    w.z = cvt_pk_bf16(p[2 * cl + 1][0], p[2 * cl + 1][1]); w.w = cvt_pk_bf16(p[2 * cl + 1][2], p[2 * cl + 1][3]);
                    pk[h][cl] = __builtin_bit_cast(bf16x8, w);
                }
            }
        }
        if (MODE == 1) {
#pragma unroll
            for (int kbl = 0; kbl < KBN; ++kbl) {
                const float a = __shfl(carh[kbl], (lane - 16) & 63);
                const float b = __shfl(prevc, (lane + 48) & 63);
                const float cp = (g == 0) ? b : a;
                { LAS float* ip = ax.impw + r * 128 + 16 * T + 4 * (hf * KBN + kbl) + g; const float nv = mainh[kbl] + cp; *ip = ax.first ? nv : (*ip + nv); }
                prevc = carh[kbl];
            }
        }
        if (MODE != 0) {
#pragma unroll
            for (int cl = 0; cl < CN; ++cl)
#pragma unroll
                for (int db = 0; db < 8; ++db) {
                    const int cc = hf * CN + cl;
                    const unsigned cho = 32u * ((unsigned)db ^ wv);
                    const s16x4 v0 = vtr(vbuf + vrow + 4096u * (2 * cc) + cho), v1 = vtr(vbuf + vrow + 4096u * (2 * cc + 1) + cho);
                    const bf16x8 vf = {v0[0], v0[1], v0[2], v0[3], v1[0], v1[1], v1[2], v1[3]};
#pragma unroll
                    for (int h = 0; h < NH; ++h) O[h][db] = __builtin_amdgcn_mfma_f32_16x16x32_bf16(vf, pk[h][cl], O[h][db], 0, 0, 0);
                    if (NH > 1 && (db & 3) == 3) __builtin_amdgcn_sched_barrier(0);
                }
        }
    }
    if (MODE == 1) ax.tc = prevc;
}

template <int NH, int MODE>
__device__ __forceinline__ void attn_run(const Ctx& c, const bf16* Kg, int ldk, const bf16* Vg, int ldv, int tile_lo, int tile_hi,
                                         const bf16x8 (&Q)[NH][4], f32x4 (&O)[NH][8], float (&m)[NH], float (&l)[NH], int t, AX& ax) {
    if (tile_lo >= tile_hi) return;
    const int q_lo = __builtin_amdgcn_readfirstlane(t) & ~127;
    constexpr int NBUF = (MODE == 0 || MODE == 1) ? 2 : 4, DIST = NBUF - 1;
    __syncthreads();
#pragma unroll
    for (int d = 0; d < DIST; ++d) if (tile_lo + d < tile_hi) stage_kv(c.lds + d * KV_BUF, Kg, ldk, Vg, ldv, 64 * (tile_lo + d), c.wid, c.lane);
    for (int T = tile_lo; T < tile_hi; ++T) {
        const int cur = (T - tile_lo) & (NBUF - 1);
        if (DIST > 1 && T + DIST - 1 < tile_hi) { if (DIST == 3) asm volatile("s_waitcnt vmcnt(8)" ::: "memory"); else asm volatile("s_waitcnt vmcnt(4)" ::: "memory"); }
        else asm volatile("s_waitcnt vmcnt(0)" ::: "memory");
        __syncthreads();
        if (T + DIST < tile_hi) stage_kv(c.lds + ((T - tile_lo + DIST) & (NBUF - 1)) * KV_BUF, Kg, ldk, Vg, ldv, 64 * (T + DIST), c.wid, c.lane);
        bool colsel = true; bool doit = true;
        if (MODE == 2) {
            const int w = T >> 5; const unsigned word = (w == 0) ? ax.sel[0] : (w == 1) ? ax.sel[1] : (w == 2) ? ax.sel[2] : ax.sel[3];
            colsel = ((word >> (T & 31)) & 1u) != 0u;
            doit = __ballot(colsel) != 0ull;
        }
        bool em = false;
        if (MODE == 0 || MODE == 1) em = (1024 * T + 1039 > q_lo);
        if (MODE == 2) em = (64 * T + 63 > q_lo);
        if (MODE == 3) em = (64 * T + 63 > q_lo) || (64 * T <= q_lo + 127 - 512);
        if (doit) {
            if (em) attn_tile<NH, MODE, true, 0>(c.lds + cur * KV_BUF, c.lds + cur * KV_BUF + 16384, Q, O, m, l, 64 * T, T, t, c.lane, colsel ? 0xffu : 0u, ax);
            else attn_tile<NH, MODE, false, 0>(c.lds + cur * KV_BUF, c.lds + cur * KV_BUF + 16384, Q, O, m, l, 64 * T, T, t, c.lane, colsel ? 0xffu : 0u, ax);
        }
    }
}

__device__ __forceinline__ void load_q(bf16x8 (&Qh)[4], const bf16* rowp, const float* rope_t, int lane) {
    const int g = lane >> 4;
#pragma unroll
    for (int s = 0; s < 4; ++s) Qh[s] = *(const bf16x8*)(rowp + 32 * s + 8 * g);
    if (rope_t) {
        const u32x4 own = __builtin_bit_cast(u32x4, Qh[0]); u32x4 par;
        par.x = __shfl_xor(own.x, 32); par.y = __shfl_xor(own.y, 32); par.z = __shfl_xor(own.z, 32); par.w = __shfl_xor(own.w, 32);
        const int f0 = 8 * (g & 1);
        const f32x4 c0 = *(const f32x4*)(rope_t + f0), c1 = *(const f32x4*)(rope_t + f0 + 4), s0 = *(const f32x4*)(rope_t + 16 + f0), s1 = *(const f32x4*)(rope_t + 16 + f0 + 4);
        const float sg = (g < 2) ? -1.f : 1.f;
        const float o0 = bflo(own.x) * c0.x + sg * bflo(par.x) * s0.x, o1 = bfhi(own.x) * c0.y + sg * bfhi(par.x) * s0.y;
        const float o2 = bflo(own.y) * c0.z + sg * bflo(par.y) * s0.z, o3 = bfhi(own.y) * c0.w + sg * bfhi(par.y) * s0.w;
        const float o4 = bflo(own.z) * c1.x + sg * bflo(par.z) * s1.x, o5 = bfhi(own.z) * c1.y + sg * bfhi(par.z) * s1.y;
        const float o6 = bflo(own.w) * c1.z + sg * bflo(par.w) * s1.z, o7 = bfhi(own.w) * c1.w + sg * bfhi(par.w) * s1.w;
        u32x4 w; w.x = cvt_pk_bf16(o0, o1); w.y = cvt_pk_bf16(o2, o3); w.z = cvt_pk_bf16(o4, o5); w.w = cvt_pk_bf16(o6, o7);
        Qh[0] = __builtin_bit_cast(bf16x8, w);
    }
}
__device__ __forceinline__ float red_g(float v) { return gsum4(v); }
__device__ __forceinline__ float sigmoidf_(float x) { return 1.0f / (1.0f + __expf(-x)); }

__device__ __forceinline__ void nsa_cmp_item(const Ctx& c, const Args& a, int nb, int grp) {
    unsigned char* ws = a.ws;
    const bf16* UNSA = (const bf16*)(ws + WS_UNSA);
    const float* ROPE = (const float*)(ws + WS_ROPE); float* TMP = (float*)(ws + WS_TMP);
    const int lane = c.lane, g = lane >> 4, r = lane & 15;
    const int t = 128 * nb + 16 * c.wid + r;
    const float NEG = -__builtin_inff();
    AX ax; ax.impw = (LAS float*)(c.lds + IMP_OFF) + c.wid * (16 * 128); ax.tc = 0.f; ax.linv[0] = ax.linv[1] = ax.linv[2] = 0.f; ax.first = true; ax.sel[0] = ax.sel[1] = ax.sel[2] = ax.sel[3] = 0u;
    const int nT = (8 * nb + 70) >> 6;
    const bf16* KCC = (const bf16*)(ws + WS_KCC) + (size_t)grp * 512 * 128; const bf16* VCC = (const bf16*)(ws + WS_VCC) + (size_t)grp * 512 * 128;
#pragma unroll 1
    for (int h = 0; h < 3; ++h) {
        const int head = 3 * grp + h;
        bf16x8 Q[1][4]; load_q(Q[0], UNSA + (size_t)t * NNSA + head * 128, ROPE + (size_t)t * 32, lane);
        f32x4 O[1][8]; float m[1], l[1];
        m[0] = NEG; l[0] = 0.f;
#pragma unroll
        for (int db = 0; db < 8; ++db) O[0][db] = (f32x4){0.f, 0.f, 0.f, 0.f};
        attn_run<1, 0>(c, KCC, 128, VCC, 128, 0, nT, Q, O, m, l, t, ax);
        { const float lt = red_g(l[0]); ax.linv[0] = lt > 0.f ? 1.0f / lt : 0.f; m[0] = (m[0] == NEG) ? 0.f : m[0]; }
        ax.tc = 0.f; ax.first = (h == 0);
        attn_run<1, 1>(c, KCC, 128, VCC, 128, 0, nT, Q, O, m, l, t, ax);
        const float gt = sigmoidf_(bf2f(UNSA[(size_t)t * NNSA + 2048 + 3 * head + 0]));
        float* tmpq = TMP + (size_t)t * QW + head * 128 + 4 * g;
#pragma unroll
        for (int db = 0; db < 8; ++db) *(f32x4*)(tmpq + 16 * db) = O[0][db] * gt;
    }
    {
        float v[32];
        int g_ = g; asm volatile("" : "+v"(g_));
        const LAS f32x4* src = (const LAS f32x4*)(ax.impw + r * 128 + 32 * g_);
#pragma unroll
        for (int k4 = 0; k4 < 8; ++k4) { const f32x4 w = src[k4]; v[4 * k4] = w.x; v[4 * k4 + 1] = w.y; v[4 * k4 + 2] = w.z; v[4 * k4 + 3] = w.w; }
        const int jt = t >> 6; const float PINF = __builtin_inff();
#pragma unroll
        for (int k = 0; k < 32; ++k) { const int j = 32 * g_ + k; v[k] = (j == 0 || j == jt || j == jt - 1) ? PINF : ((j > jt) ? NEG : v[k]); }
        unsigned selown = 0u;
#pragma unroll 1
        for (int round = 0; round < 16; ++round) {
            float bv = v[0]; int bk = 0;
#pragma unroll
            for (int k = 1; k < 32; ++k) { const bool gt = v[k] > bv; bv = gt ? v[k] : bv; bk = gt ? k : bk; }
            int bidx = 32 * g_ + bk;
#pragma unroll
            for (int o = 16; o <= 32; o <<= 1) { const float ov = __shfl_xor(bv, o); const int oi = __shfl_xor(bidx, o); const bool take = (ov > bv) || (ov == bv && oi < bidx); bv = take ? ov : bv; bidx = take ? oi : bidx; }
            const bool mine = (bidx >> 5) == g_; const int kk = bidx & 31;
            selown |= mine ? (1u << kk) : 0u;
#pragma unroll
            for (int k = 0; k < 32; ++k) v[k] = (mine && k == kk) ? NEG : v[k];
        }
        ((unsigned*)(ws + WS_SELB))[((size_t)t * 4 + grp) * 4 + g_] = selown;
    }
}

__device__ __forceinline__ void nsa_sw_item(const Ctx& c, const Args& a, int nb, int head) {
    unsigned char* ws = a.ws;
    const bf16* UNSA = (const bf16*)(ws + WS_UNSA); const bf16* UKV = (const bf16*)(ws + WS_UKV);
    const float* ROPE = (const float*)(ws + WS_ROPE); const float* TMP = (const float*)(ws + WS_TMP); bf16* CAT = (bf16*)(ws + WS_CAT);
    const int lane = c.lane, g = lane >> 4, r = lane & 15, grp = head / 3;
    const int t = 128 * nb + 16 * c.wid + r;
    const float NEG = -__builtin_inff();
    AX ax; ax.impw = nullptr; ax.tc = 0.f; ax.linv[0] = ax.linv[1] = ax.linv[2] = 0.f; ax.first = true;
    { const u32x4 sw = *(const u32x4*)((const unsigned*)(ws + WS_SELB) + ((size_t)t * 4 + grp) * 4); ax.sel[0] = sw.x; ax.sel[1] = sw.y; ax.sel[2] = sw.z; ax.sel[3] = sw.w; }
    bf16x8 Q[1][4]; load_q(Q[0], UNSA + (size_t)t * NNSA + head * 128, ROPE + (size_t)t * 32, lane);
    f32x4 O[1][8]; float m[1], l[1];
    m[0] = NEG; l[0] = 0.f;
#pragma unroll
    for (int db = 0; db < 8; ++db) O[0][db] = (f32x4){0.f, 0.f, 0.f, 0.f};
    attn_run<1, 2>(c, (const bf16*)(ws + WS_KSR) + (size_t)grp * S * 128, 128, UKV + 1536 + grp * 128, NKV, 0, 2 * nb + 2, Q, O, m, l, t, ax);
    f32x4 acc[8];
    { const float lt = red_g(l[0]); const float sc = (lt > 0.f ? 1.0f / lt : 0.f) * sigmoidf_(bf2f(UNSA[(size_t)t * NNSA + 2048 + 3 * head + 1]));
      const float* tmpq = TMP + (size_t)t * QW + head * 128 + 4 * g;
#pragma unroll
      for (int db = 0; db < 8; ++db) acc[db] = *(const f32x4*)(tmpq + 16 * db) + O[0][db] * sc; }
    m[0] = NEG; l[0] = 0.f;
#pragma unroll
    for (int db = 0; db < 8; ++db) O[0][db] = (f32x4){0.f, 0.f, 0.f, 0.f};
    attn_run<1, 3>(c, (const bf16*)(ws + WS_KWR) + (size_t)grp * S * 128, 128, UKV + 2560 + grp * 128, NKV, (2 * nb - 8) > 0 ? (2 * nb - 8) : 0, 2 * nb + 2, Q, O, m, l, t, ax);
    { const float lt = red_g(l[0]); const float sc = (lt > 0.f ? 1.0f / lt : 0.f) * sigmoidf_(bf2f(UNSA[(size_t)t * NNSA + 2048 + 3 * head + 2]));
      bf16* catq = CAT + (size_t)t * D + head * 128 + 4 * g;
#pragma unroll
      for (int db = 0; db < 8; ++db) { const f32x4 o = acc[db] + O[0][db] * sc; u32x2 w; w.x = cvt_pk_bf16(o.x, o.y); w.y = cvt_pk_bf16(o.z, o.w); *(u32x2*)(catq + 16 * db) = w; } }
}

struct AX2 { const LAS unsigned* selw; };
constexpr int SELW_OFF = 131072;
template <int MODE>
__device__ __forceinline__ void attn_run2(const Ctx& c, const bf16* Kg, int ldk, const bf16* Vg, int ldv, int tile_lo, int tile_hi,
                                          const bf16x8 (&Q)[2][4], f32x4 (&O)[2][8], float (&m)[2], float (&l)[2], int t0, const AX2& a2, AX& ax, int lane) {
    const int kh = c.wid >> 2, qs = c.wid & 3;
    const int q_lo = __builtin_amdgcn_readfirstlane(t0) & ~127;
    const int npairs = (tile_hi - tile_lo + 1) >> 1;
    __syncthreads();
    if (npairs > 0) { stage_kv(c.lds, Kg, ldk, Vg, ldv, 64 * tile_lo, c.wid, lane); if (tile_lo + 1 < tile_hi) stage_kv(c.lds + KV_BUF, Kg, ldk, Vg, ldv, 64 * (tile_lo + 1), c.wid, lane); }
    for (int pi = 0; pi < npairs; ++pi) {
        const int cur = pi & 1;
        asm volatile("s_waitcnt vmcnt(0)" ::: "memory");
        __syncthreads();
        if (pi + 1 < npairs) { const int Tn = tile_lo + 2 * (pi + 1);
            stage_kv(c.lds + (cur ^ 1) * 2 * KV_BUF, Kg, ldk, Vg, ldv, 64 * Tn, c.wid, lane);
            if (Tn + 1 < tile_hi) stage_kv(c.lds + (cur ^ 1) * 2 * KV_BUF + KV_BUF, Kg, ldk, Vg, ldv, 64 * (Tn + 1), c.wid, lane); }
        const int T = tile_lo + 2 * pi + kh;
        if (T < tile_hi) {
            unsigned csel = 3u; bool doit = true;
            if (MODE == 2) {
                const int w = T >> 5;
                const unsigned w0 = a2.selw[(lane & 15) * 4 + w], w1 = a2.selw[(16 + (lane & 15)) * 4 + w];
                csel = ((w0 >> (T & 31)) & 1u) | (((w1 >> (T & 31)) & 1u) << 1);
                doit = __ballot(csel != 0u) != 0ull;
            }
            bool em = false;
            if (MODE == 2) em = (64 * T + 63 > q_lo);
            if (MODE == 3) em = (64 * T + 63 > q_lo) || (64 * T <= q_lo + 127 - 512);
            LAS unsigned char* kb_ = c.lds + cur * 2 * KV_BUF + kh * KV_BUF;
            if (doit) {
                if (em) attn_tile<2, MODE, true, 16>(kb_, kb_ + 16384, Q, O, m, l, 64 * T, T, t0, lane, csel, ax);
                else attn_tile<2, MODE, false, 16>(kb_, kb_ + 16384, Q, O, m, l, 64 * T, T, t0, lane, csel, ax);
            }
        }
    }
    __syncthreads();
    LAS float* mb = (LAS float*)c.lds + qs * (68 * 64) + lane;
    if (kh == 1) {
#pragma unroll
        for (int b = 0; b < 2; ++b) { mb[(b * 34 + 0) * 64] = m[b]; mb[(b * 34 + 1) * 64] = l[b];
#pragma unroll
            for (int db = 0; db < 8; ++db) { mb[(b * 34 + 2 + 4 * db) * 64] = O[b][db].x; mb[(b * 34 + 3 + 4 * db) * 64] = O[b][db].y; mb[(b * 34 + 4 + 4 * db) * 64] = O[b][db].z; mb[(b * 34 + 5 + 4 * db) * 64] = O[b][db].w; } }
    }
    __syncthreads();
    if (kh == 0) {
        const float NEG = -__builtin_inff();
#pragma unroll
        for (int b = 0; b < 2; ++b) { const float mo = mb[(b * 34 + 0) * 64], lo_ = mb[(b * 34 + 1) * 64];
            const float mn = fmaxf(m[b], mo); const float mu = (mn == NEG) ? 0.f : mn; const float sa = fexp2(m[b] - mu), sb = fexp2(mo - mu);
            l[b] = l[b] * sa + lo_ * sb; m[b] = mn;
#pragma unroll
            for (int db = 0; db < 8; ++db) { f32x4 o; o.x = mb[(b * 34 + 2 + 4 * db) * 64]; o.y = mb[(b * 34 + 3 + 4 * db) * 64]; o.z = mb[(b * 34 + 4 + 4 * db) * 64]; o.w = mb[(b * 34 + 5 + 4 * db) * 64];
                O[b][db] = O[b][db] * sa + o * sb; } }
    }
}

__device__ __forceinline__ void nsa_sw_item2(const Ctx& c, const Args& a, int nb, int head) {
    unsigned char* ws = a.ws;
    const bf16* UNSA = (const bf16*)(ws + WS_UNSA); const bf16* UKV = (const bf16*)(ws + WS_UKV);
    const float* ROPE = (const float*)(ws + WS_ROPE); float* TMP = (float*)(ws + WS_TMP); bf16* CAT = (bf16*)(ws + WS_CAT);
    int lane = c.lane; asm volatile("" : "+v"(lane));
    const int g = lane >> 4, r = lane & 15, grp = head / 3, kh = c.wid >> 2, qs = c.wid & 3;
    const int t0 = 128 * nb + 32 * qs + r;
    const float NEG = -__builtin_inff();
    AX ax; ax.impw = nullptr; ax.tc = 0.f; ax.linv[0] = ax.linv[1] = ax.linv[2] = 0.f; ax.first = true; ax.sel[0] = ax.sel[1] = ax.sel[2] = ax.sel[3] = 0u;
    AX2 a2; a2.selw = (const LAS unsigned*)(c.lds + SELW_OFF) + (32 * qs) * 4;
    bf16x8 Q[2][4];
#pragma unroll
    for (int b = 0; b < 2; ++b) { const int tb = t0 + 16 * b;
        ((LAS unsigned*)(c.lds + SELW_OFF))[(32 * qs + 16 * b + r) * 4 + g] = ((const unsigned*)(ws + WS_SELB))[((size_t)tb * 4 + grp) * 4 + g];
        load_q(Q[b], UNSA + (size_t)tb * NNSA + head * 128, ROPE + (size_t)tb * 32, lane); }
    f32x4 O[2][8]; float m[2], l[2];
#pragma unroll
    for (int b = 0; b < 2; ++b) { m[b] = NEG; l[b] = 0.f;
#pragma unroll
        for (int db = 0; db < 8; ++db) O[b][db] = (f32x4){0.f, 0.f, 0.f, 0.f}; }
    attn_run2<2>(c, (const bf16*)(ws + WS_KSR) + (size_t)grp * S * 128, 128, UKV + 1536 + grp * 128, NKV, 0, 2 * nb + 2, Q, O, m, l, t0, a2, ax, lane);
    if (kh == 0) {
#pragma unroll
        for (int b = 0; b < 2; ++b) { const int tb = t0 + 16 * b; const float lt = red_g(l[b]); const float sc = (lt > 0.f ? 1.0f / lt : 0.f) * sigmoidf_(bf2f(UNSA[(size_t)tb * NNSA + 2048 + 3 * head + 1]));
            float* tmpq = TMP + (size_t)tb * QW + head * 128 + 4 * g;
#pragma unroll
            for (int db = 0; db < 8; ++db) { f32x4* p = (f32x4*)(tmpq + 16 * db); *p = *p + O[b][db] * sc; } }
    }
#pragma unroll
    for (int b = 0; b < 2; ++b) { m[b] = NEG; l[b] = 0.f;
#pragma unroll
        for (int db = 0; db < 8; ++db) O[b][db] = (f32x4){0.f, 0.f, 0.f, 0.f}; }
    attn_run2<3>(c, (const bf16*)(ws + WS_KWR) + (size_t)grp * S * 128, 128, UKV + 2560 + grp * 128, NKV, (2 * nb - 8) > 0 ? (2 * nb - 8) : 0, 2 * nb + 2, Q, O, m, l, t0, a2, ax, lane);
    if (kh == 0) {
#pragma unroll
        for (int b = 0; b < 2; ++b) { const int tb = t0 + 16 * b; const float lt = red_g(l[b]); const float sc = (lt > 0.f ? 1.0f / lt : 0.f) * sigmoidf_(bf2f(UNSA[(size_t)tb * NNSA + 2048 + 3 * head + 2]));
            const float* tmpq = TMP + (size_t)tb * QW + head * 128 + 4 * g; bf16* catq = CAT + (size_t)tb * D + head * 128 + 4 * g;
#pragma unroll
            for (int db = 0; db < 8; ++db) { const f32x4 o = *(const f32x4*)(tmpq + 16 * db) + O[b][db] * sc; u32x2 w; w.x = cvt_pk_bf16(o.x, o.y); w.y = cvt_pk_bf16(o.z, o.w); *(u32x2*)(catq + 16 * db) = w; } }
    }
}

__device__ __forceinline__ void mem_item(const Ctx& c, const Args& a, const bf16* qsrc, int ldq, int qcol, const bf16* memkv, int qb, int head) {
    const int lane = c.lane, g = lane >> 4, r = lane & 15;
    const int t = 128 * qb + 16 * c.wid + r;
    bf16x8 Q[1][4]; load_q(Q[0], qsrc + (size_t)t * ldq + qcol + head * 128, nullptr, lane);
    f32x4 O[1][8]; float m[1], l[1]; AX ax; ax.impw = nullptr; ax.first = true; ax.sel[0] = ax.sel[1] = ax.sel[2] = ax.sel[3] = 0u; ax.tc = 0.f; ax.linv[0] = ax.linv[1] = ax.linv[2] = 0.f;
    m[0] = -__builtin_inff(); l[0] = 0.f;
#pragma unroll
    for (int db = 0; db < 8; ++db) O[0][db] = (f32x4){0.f, 0.f, 0.f, 0.f};
    attn_run<1, 4>(c, memkv + head * 128, MEMKVW, memkv + 512 + head * 128, MEMKVW, 0, NMEM / 64, Q, O, m, l, t, ax);
    const float lt = red_g(l[0]); const float sc = lt > 0.f ? 1.0f / lt : 0.f;
    bf16* catq = (bf16*)(a.ws + WS_CAT) + (size_t)t * D + QW + head * 128 + 4 * g;
#pragma unroll
    for (int db = 0; db < 8; ++db) { const f32x4 o = O[0][db] * sc; u32x2 w; w.x = cvt_pk_bf16(o.x, o.y); w.y = cvt_pk_bf16(o.z, o.w); *(u32x2*)(catq + 16 * db) = w; }
}

__device__ __forceinline__ void unpack8(const u32x4 w, float (&f)[8]) { f[0] = bflo(w.x); f[1] = bfhi(w.x); f[2] = bflo(w.y); f[3] = bfhi(w.y); f[4] = bflo(w.z); f[5] = bfhi(w.z); f[6] = bflo(w.w); f[7] = bfhi(w.w); }
__device__ __forceinline__ u32x4 pack8(const float (&f)[8]) { u32x4 w; w.x = cvt_pk_bf16(f[0], f[1]); w.y = cvt_pk_bf16(f[2], f[3]); w.z = cvt_pk_bf16(f[4], f[5]); w.w = cvt_pk_bf16(f[6], f[7]); return w; }

__device__ __forceinline__ void conv_phase(const Ctx& c, const Args& a) {
    const bf16* U = (const bf16*)(a.ws + WS_UCONV); bf16* CAT = (bf16*)(a.ws + WS_CAT); const float* cw = (const float*)a.in[12];
    for (int idx = c.bid * NTHREADS + c.tid; idx < S * (CONVC / 8); idx += c.G * NTHREADS) {
        const int t = idx / (CONVC / 8), ch = (idx - t * (CONVC / 8)) * 8;
        float acc[8] = {0.f, 0.f, 0.f, 0.f, 0.f, 0.f, 0.f, 0.f};
#pragma unroll
        for (int k = 0; k < 3; ++k) { const int tt = t - 2 + k;
            if (tt >= 0) { float gc[8], hv[8]; unpack8(*(const u32x4*)(U + (size_t)tt * NCONV + CONVC + ch), gc); unpack8(*(const u32x4*)(U + (size_t)tt * NCONV + 2 * CONVC + ch), hv);
                const f32x4 w0 = *(const f32x4*)(cw + k * CONVC + ch), w1 = *(const f32x4*)(cw + k * CONVC + ch + 4);
                acc[0] += w0.x * (gc[0] * hv[0]); acc[1] += w0.y * (gc[1] * hv[1]); acc[2] += w0.z * (gc[2] * hv[2]); acc[3] += w0.w * (gc[3] * hv[3]);
                acc[4] += w1.x * (gc[4] * hv[4]); acc[5] += w1.y * (gc[5] * hv[5]); acc[6] += w1.z * (gc[6] * hv[6]); acc[7] += w1.w * (gc[7] * hv[7]); } }
        float gb[8]; unpack8(*(const u32x4*)(U + (size_t)t * NCONV + ch), gb);
#pragma unroll
        for (int j = 0; j < 8; ++j) acc[j] *= gb[j];
        *(u32x4*)(CAT + (size_t)t * D + ch) = pack8(acc);
    }
}

__device__ __forceinline__ void kvpost_phase(const Ctx& c, const Args& a, int wbase, int widx, int nwork) {
    const bf16* UKV = (const bf16*)(a.ws + WS_UKV); const float* ROPE = (const float*)(a.ws + WS_ROPE);
    for (int idx = widx * NTHREADS + c.tid; idx < S * 128; idx += nwork * NTHREADS) {
        const int t = idx >> 7, rem = idx & 127, which = wbase + (rem >> 6), grp = (rem >> 4) & 3, ch = rem & 15;
        const int colbase = (which == 0) ? 0 : (which == 1) ? 512 : (which == 2) ? 1024 : 2048;
        const size_t dsto = (which == 0) ? WS_KCR : (which == 1) ? WS_VCR : (which == 2) ? WS_KSR : WS_KWR;
        const bf16* src = UKV + (size_t)t * NKV + colbase + grp * 128;
        bf16* dst = (bf16*)(a.ws + dsto) + ((size_t)grp * S + t) * 128;
        u32x4 own = *(const u32x4*)(src + 8 * ch);
        if (which != 1 && ch < 4) {
            const u32x4 par = *(const u32x4*)(src + 8 * (ch ^ 2));
            float xo[8], xp[8], o[8]; unpack8(own, xo); unpack8(par, xp);
            const float* rt = ROPE + (size_t)t * 32 + 8 * (ch & 1); const float sg = (ch < 2) ? -1.f : 1.f;
#pragma unroll
            for (int j = 0; j < 8; ++j) o[j] = xo[j] * rt[j] + sg * xp[j] * rt[16 + j];
            own = pack8(o);
        }
        *(u32x4*)(dst + 8 * ch) = own;
    }
}

__device__ __forceinline__ float gelu_tanh(float x) { const float y = 0.7978845608028654f * (x + 0.044715f * x * x * x); const float e = __expf(2.0f * y); const float th = 1.0f - 2.0f / (e + 1.0f); return 0.5f * x * (1.0f + th); }
__device__ __forceinline__ void compress_item(const Ctx& c, const bf16* src, const float* pos, const bf16* w1t, const bf16* w2t, bf16* dst, int rg) {
    const int lane = c.lane, g = lane >> 4, r = lane & 15, wid = c.wid;
    const int mrow = 16 * rg + r;
    const bf16* arow = src + (size_t)mrow * 2048;
    f32x4 acc[8];
#pragma unroll
    for (int nb = 0; nb < 8; ++nb) acc[nb] = (f32x4){0.f, 0.f, 0.f, 0.f};
#pragma unroll 2
    for (int ks = 0; ks < 16; ++ks) {
        const int k = 512 * wid + 32 * ks + 8 * g;
        float xa[8]; unpack8(*(const u32x4*)(arow + k), xa);
        const f32x4 p0 = *(const f32x4*)(pos + k), p1 = *(const f32x4*)(pos + k + 4);
        xa[0] += p0.x; xa[1] += p0.y; xa[2] += p0.z; xa[3] += p0.w; xa[4] += p1.x; xa[5] += p1.y; xa[6] += p1.z; xa[7] += p1.w;
        const bf16x8 xb = __builtin_bit_cast(bf16x8, pack8(xa));
#pragma unroll
        for (int nb = 0; nb < 8; ++nb) { const bf16x8 wf = *(const bf16x8*)(w1t + (size_t)(16 * nb + r) * 4096 + k); acc[nb] = __builtin_amdgcn_mfma_f32_16x16x32_bf16(wf, xb, acc[nb], 0, 0, 0); }
    }
    LAS f32x4* red = (LAS f32x4*)c.lds;
    __syncthreads();
#pragma unroll
    for (int nb = 0; nb < 8; ++nb) red[(wid * 8 + nb) * 64 + lane] = acc[nb];
    __syncthreads();
    if (wid == 0) {
        float hid[8][4];
#pragma unroll
        for (int nb = 0; nb < 8; ++nb) { f32x4 s = red[nb * 64 + lane];
#pragma unroll
            for (int w = 1; w < 8; ++w) s = s + red[(w * 8 + nb) * 64 + lane];
            hid[nb][0] = gelu_tanh(s.x); hid[nb][1] = gelu_tanh(s.y); hid[nb][2] = gelu_tanh(s.z); hid[nb][3] = gelu_tanh(s.w); }
        f32x4 o2[8];
#pragma unroll
        for (int ob = 0; ob < 8; ++ob) o2[ob] = (f32x4){0.f, 0.f, 0.f, 0.f};
#pragma unroll
        for (int cc = 0; cc < 4; ++cc) {
            u32x4 bw; bw.x = cvt_pk_bf16(hid[2 * cc][0], hid[2 * cc][1]); bw.y = cvt_pk_bf16(hid[2 * cc][2], hid[2 * cc][3]); bw.z = cvt_pk_bf16(hid[2 * cc + 1][0], hid[2 * cc + 1][1]); bw.w = cvt_pk_bf16(hid[2 * cc + 1][2], hid[2 * cc + 1][3]);
            const bf16x8 bfrag = __builtin_bit_cast(bf16x8, bw);
#pragma unroll
            for (int ob = 0; ob < 8; ++ob) { const bf16* wr_ = w2t + (size_t)(16 * ob + r) * 128 + 32 * cc + 4 * g;
                const u32x2 a0 = *(const u32x2*)wr_, a1 = *(const u32x2*)(wr_ + 16);
                u32x4 aw; aw.x = a0.x; aw.y = a0.y; aw.z = a1.x; aw.w = a1.y;
                o2[ob] = __builtin_amdgcn_mfma_f32_16x16x32_bf16(__builtin_bit_cast(bf16x8, aw), bfrag, o2[ob], 0, 0, 0); }
        }
#pragma unroll
        for (int ob = 0; ob < 8; ++ob) { u32x2 w; w.x = cvt_pk_bf16(o2[ob].x, o2[ob].y); w.y = cvt_pk_bf16(o2[ob].z, o2[ob].w); *(u32x2*)(dst + (size_t)mrow * 128 + 16 * ob + 4 * g) = w; }
    }
}

#define XB_TMO      128
#define XB_XCNT(j)  (256  + 64 * (j))
#define XB_XSUB(j)  (1280 + 64 * (j))
#define XB_XGEN(j)  (2304 + 64 * (j))
#define XB_TOP      3328
#define XB_TOPGEN   3392
#define XCD_BAR_WORDS 3456
#define XB_SPIN_CAP (1u << 18)

__device__ __forceinline__ unsigned xb_ld(unsigned* p)              { return __hip_atomic_load(p, __ATOMIC_RELAXED, __HIP_MEMORY_SCOPE_AGENT); }
__device__ __forceinline__ unsigned xb_add(unsigned* p, unsigned v) { return __hip_atomic_fetch_add(p, v, __ATOMIC_RELAXED, __HIP_MEMORY_SCOPE_AGENT); }
__device__ __forceinline__ unsigned xb_xcc_id() { return (unsigned)__builtin_amdgcn_s_getreg((3 << 11) | 20) & 0xFu; }
#define XB_SPIN(cond, bar) do { unsigned _sp = 0; while (cond) { __builtin_amdgcn_s_sleep(1); \
    if ((++_sp & 255u) == 0u) { if (xb_ld(&(bar)[XB_TMO])) break; if (_sp > XB_SPIN_CAP) { atomicAdd(&(bar)[XB_TMO], 1u); break; } } } } while (0)

struct XcdBarrier {
    unsigned* bar; unsigned x;
    volatile LAS unsigned* st;
};

__device__ __forceinline__ XcdBarrier xcd_barrier_post(unsigned* bar, volatile LAS unsigned* st) {
    XcdBarrier b; b.bar = bar; b.x = xb_xcc_id(); b.st = st;
    if (threadIdx.x == 0) (void)xb_add(&bar[XB_XCNT(b.x)], 1u);
    return b;
}
__device__ __forceinline__ void xcd_barrier_complete(unsigned* bar, unsigned x, unsigned& nloc, unsigned& nx) {
    const unsigned G = gridDim.x * gridDim.y * gridDim.z;
    unsigned sum, cnt, mine, sp = 0u;
    for (;;) {
        sum = 0u; cnt = 0u; mine = 0u;
#pragma unroll
        for (unsigned j = 0; j < 16; ++j) { const unsigned c = xb_ld(&bar[XB_XCNT(j)]); sum += c; cnt += (c > 0u) ? 1u : 0u; mine = (j == x) ? c : mine; }
        if (sum == G) break;
        __builtin_amdgcn_s_sleep(1);
        if ((++sp & 255u) == 0u) { if (xb_ld(&bar[XB_TMO])) break; if (sp > XB_SPIN_CAP) { atomicAdd(&bar[XB_TMO], 1u); break; } }
    }
    nloc = mine > 0u ? mine : 1u; nx = cnt > 0u ? cnt : 1u;
}

__device__ __forceinline__ void xcd_barrier(const XcdBarrier& b) {
    asm volatile("s_waitcnt vmcnt(0)" ::: "memory");
    __syncthreads();
    if (threadIdx.x == 0) {
        unsigned* bar = b.bar;
        __builtin_amdgcn_s_waitcnt(0);
        unsigned nloc = b.st[0], nx = b.st[1];
        if (nloc == 0u) { xcd_barrier_complete(bar, b.x, nloc, nx); b.st[0] = nloc; b.st[1] = nx; }
        const unsigned old = xb_add(&bar[XB_XSUB(b.x)], 1u);
        const unsigned gen = old / nloc;
        if (old + 1u == (gen + 1u) * nloc) {
            __builtin_amdgcn_fence(__ATOMIC_RELEASE, "agent");
            asm volatile("s_waitcnt vmcnt(0)" ::: "memory");
            const unsigned og = xb_add(&bar[XB_TOP], 1u);
            const unsigned tg = og / nx;
            if (og + 1u == (tg + 1u) * nx) xb_add(&bar[XB_TOPGEN], 1u);
            else XB_SPIN(xb_ld(&bar[XB_TOPGEN]) == tg, bar);
            __builtin_amdgcn_fence(__ATOMIC_ACQUIRE, "agent");
            xb_add(&bar[XB_XGEN(b.x)], 1u);
            asm volatile("s_waitcnt vmcnt(0)" ::: "memory");
        } else {
            XB_SPIN(xb_ld(&bar[XB_XGEN(b.x)]) == gen, bar);
            __builtin_amdgcn_fence(__ATOMIC_ACQUIRE, "agent");
            asm volatile("s_waitcnt vmcnt(0)" ::: "memory");
        }
    }
    __syncthreads();
}

constexpr int MISC_OFF = 131072 + 2048;
__device__ const unsigned short SW_OFF[257] = {0,2,4,6,8,10,12,14,16,18,20,22,24,26,28,30,32,34,36,38,40,42,44,46,48,50,52,54,56,58,60,62,64,66,68,70,72,74,76,78,80,82,84,86,88,90,92,94,96,98,100,102,104,106,108,110,112,114,116,118,120,122,124,126,128,130,132,134,136,138,140,142,144,146,148,150,152,154,156,158,160,162,164,166,168,170,172,174,176,178,180,182,184,186,188,190,192,194,196,198,200,202,204,206,208,210,212,214,216,218,220,222,224,226,228,230,232,234,236,238,240,242,244,246,248,250,252,254,256,258,260,262,264,266,268,270,272,274,276,278,280,282,284,286,288,290,292,294,296,298,300,302,304,306,308,310,312,316,320,324,328,333,338,343,348,353,358,363,368,372,376,380,384,389,394,399,404,409,414,419,424,428,432,436,440,445,450,455,460,465,470,475,480,484,488,492,496,501,506,511,516,521,526,531,536,540,544,548,552,557,562,567,572,577,582,587,592,596,600,604,608,613,618,623,628,633,638,643,648,652,656,660,664,669,674,679,684,689,694,699,704,708,712,716,720,724,728,732,736,740,744,748,752,756,760,764,768};
__device__ const unsigned short SW_TAB[768] = {0,300,1,301,2,302,3,303,4,304,5,305,6,306,7,307,8,308,9,309,10,310,11,311,12,288,13,289,14,290,15,291,16,292,17,293,18,294,19,295,20,296,21,297,22,298,23,299,24,276,25,277,26,278,27,279,28,280,29,281,30,282,31,283,32,284,33,285,34,286,35,287,36,264,37,265,38,266,39,267,40,268,41,269,42,270,43,271,44,272,45,273,46,274,47,275,48,252,49,253,50,254,51,255,52,256,53,257,54,258,55,259,56,260,57,261,58,262,59,263,60,240,61,241,62,242,63,243,64,244,65,245,66,246,67,247,68,248,69,249,70,250,71,251,72,228,73,229,74,230,75,231,76,232,77,233,78,234,79,235,80,236,81,237,82,238,83,239,84,216,85,217,86,218,87,219,88,220,89,221,90,222,91,223,92,224,93,225,94,226,95,227,96,204,97,205,98,206,99,207,100,208,101,209,102,210,103,211,104,212,105,213,106,214,107,215,108,192,109,193,110,194,111,195,112,196,113,197,114,198,115,199,116,200,117,201,118,202,119,203,120,180,121,181,122,182,123,183,124,184,125,185,126,186,127,187,128,188,129,189,130,190,131,191,132,168,133,169,134,170,135,171,136,172,137,173,138,174,139,175,140,176,141,177,142,178,143,179,144,156,145,157,146,158,147,159,148,160,149,161,150,162,151,163,152,164,153,165,154,166,155,167,312,500,524,640,313,501,525,641,314,502,526,642,315,503,527,643,316,512,600,708,712,317,513,601,709,713,318,514,602,710,714,319,515,603,711,715,320,516,604,696,716,321,517,605,697,717,322,518,606,698,718,323,519,607,699,719,324,488,528,644,325,489,529,645,326,490,530,646,327,491,531,647,328,492,576,700,720,329,493,577,701,721,330,494,578,702,722,331,495,579,703,723,332,496,580,704,724,333,497,581,705,725,334,498,582,706,726,335,499,583,707,727,336,476,532,624,337,477,533,625,338,478,534,626,339,479,535,627,340,480,584,684,728,341,481,585,685,729,342,482,586,686,730,343,483,587,687,731,344,484,588,688,732,345,485,589,689,733,346,486,590,690,734,347,487,591,691,735,348,464,536,628,349,465,537,629,350,466,538,630,351,467,539,631,352,468,592,692,736,353,469,593,693,737,354,470,594,694,738,355,471,595,695,739,356,472,596,672,740,357,473,597,673,741,358,474,598,674,742,359,475,599,675,743,360,452,540,632,361,453,541,633,362,454,542,634,363,455,543,635,364,456,544,676,744,365,457,545,677,745,366,458,546,678,746,367,459,547,679,747,368,460,548,680,748,369,461,549,681,749,370,462,550,682,750,371,463,551,683,751,372,440,568,612,373,441,569,613,374,442,570,614,375,443,571,615,376,444,552,660,752,377,445,553,661,753,378,446,554,662,754,379,447,555,663,755,380,448,556,664,756,381,449,557,665,757,382,450,558,666,758,383,451,559,667,759,384,428,572,616,385,429,573,617,386,430,574,618,387,431,575,619,388,432,560,668,760,389,433,561,669,761,390,434,562,670,762,391,435,563,671,763,392,436,564,648,764,393,437,565,649,765,394,438,566,650,766,395,439,567,651,767,396,416,608,620,397,417,609,621,398,418,610,622,399,419,611,623,400,420,504,652,401,421,505,653,402,422,506,654,403,423,507,655,404,424,508,656,405,425,509,657,406,426,510,658,407,427,511,659,408,412,520,636,409,413,521,637,410,414,522,638,411,415,523,639};
#ifndef REPEAT_MASK
#define REPEAT_MASK 0u
#endif
__device__ __forceinline__ bool refresh(Ctx& c, int rep) { if (rep) __syncthreads(); int tid = threadIdx.x; asm volatile("" : "+v"(tid)); c.tid = tid; c.lane = tid & 63; return true; }
__global__ void __launch_bounds__(NTHREADS) fwd_megakernel(Args a) {
    extern __shared__ __attribute__((aligned(16))) unsigned char lds_raw[];
    __builtin_assume(__builtin_amdgcn_workitem_id_y() == 0); __builtin_assume(__builtin_amdgcn_workitem_id_z() == 0);
    cg::grid_group grid = cg::this_grid();
    Ctx c; c.lds = (LAS unsigned char*)lds_raw; c.tid = threadIdx.x; c.lane = c.tid & 63; c.wid = __builtin_amdgcn_readfirstlane(c.tid >> 6); c.G = gridDim.x; c.bid = blockIdx.x;
    unsigned char* ws = a.ws;
    const float* x = (const float*)a.in[0];
    float* SS = (float*)(ws + WS_SS); const float* kv_norm = (const float*)a.in[14];
    float* H = (float*)(ws + WS_H); bf16* XN = (bf16*)(ws + WS_XN); bf16* XKV = (bf16*)(ws + WS_XKV); bf16* ACT = (bf16*)(ws + WS_ACT);
    bf16* UCONV = (bf16*)(ws + WS_UCONV); bf16* UNSA = (bf16*)(ws + WS_UNSA); bf16* UKV = (bf16*)(ws + WS_UKV); bf16* CAT = (bf16*)(ws + WS_CAT);
    const float* ffn_norm = (const float*)a.in[3]; const float* mix_norm = (const float*)a.in[7];
    const int lo = a.ph_lo, hi = a.ph_hi;
    volatile LAS unsigned* MISC = (volatile LAS unsigned*)(c.lds + MISC_OFF);
    if (c.tid < 2) MISC[c.tid] = 0u;
    __syncthreads();
    XcdBarrier bar; bar.bar = (unsigned*)(ws + WS_CTL); bar.x = 0; bar.st = MISC;
    if (hi - lo > 1) bar = xcd_barrier_post((unsigned*)(ws + WS_CTL), MISC);
    const int rc = c.G - 1 - c.bid;
#define PH(k) if (lo <= (k) && (k) < hi) for (int rep_ = 0; rep_ <= (int)((REPEAT_MASK >> (k)) & 1u); ++rep_) if (refresh(c, rep_))
#define SYNC(k) if (lo <= (k) && (k) + 1 < hi) { xcd_barrier(bar); }
#define WGU(f) ((const bf16*)(ws + WS_WGU + (size_t)(f) * SZ_WGU))
#define WD(f) ((const bf16*)(ws + WS_WD + (size_t)(f) * SZ_WD))
    if (hi < 0) grid.sync();
    PH(0) { prologue(c, a); } SYNC(0)
    PH(1) { run_gemm(c, XN, WGU(0), S, NGU, D, EpiSwiGLU{ACT, FF}, c.bid);
            run_gemm(c, (const bf16*)(ws + WS_MEMN), (const bf16*)(ws + WS_WMEM), NMEM, MEMKVW, D, EpiPlain{(bf16*)(ws + WS_MEMKV), MEMKVW}, rc);
            run_gemm(c, (const bf16*)(ws + WS_MEMN + (size_t)NMEM * D * 2), (const bf16*)(ws + WS_WMEM + (size_t)MEMKVW * D * 2), NMEM, MEMKVW, D, EpiPlain{(bf16*)(ws + WS_MEMKV + (size_t)NMEM * MEMKVW * 2), MEMKVW}, (rc + c.G - 4) % c.G);
            if (c.G == 256 && c.bid >= 128 && c.bid < 248) convert_segs(c, a, CV_P1, c.bid - 128, 120); } SYNC(1)
    PH(2) { run_gemm(c, ACT, WD(0), S, D, FF, EpiRes{x, H, D, 0.5f, SS, XN}, c.bid); } SYNC(2)
    PH(4) { run_gemm(c, XN, (const bf16*)(ws + WS_WCONV), S, NCONV, D, EpiPlain{UCONV, NCONV, SS}, c.bid);
            if (c.G == 256 && c.bid >= 128) convert_segs(c, a, CV_P4, c.bid - 128, 128); } SYNC(4)
    PH(5) { conv_phase(c, a);
            for (int it = c.bid; it < 256; it += c.G) mem_item(c, a, UCONV, NCONV, 3 * CONVC, (const bf16*)(ws + WS_MEMKV), it >> 2, it & 3); } SYNC(5)
    PH(6) { run_gemm(c, CAT, (const bf16*)(ws + WS_WOUT), S, D, D, EpiRes{H, H, D, 1.0f, SS + S, XN}, c.bid); } SYNC(6)
    PH(8) { run_gemm(c, XN, WGU(1), S, NGU, D, EpiSwiGLU{ACT, FF, SS + S}, c.bid);
            if (c.G == 256 && c.bid >= 128) convert_segs(c, a, CV_P8, c.bid - 128, 128); } SYNC(8)
    PH(9) { run_gemm(c, ACT, WD(1), S, D, FF, EpiRes{H, H, D, 0.5f, SS + 2 * S, XN}, c.bid); } SYNC(9)
    PH(11) { run_gemm(c, XN, WGU(2), S, NGU, D, EpiSwiGLU{ACT, FF, SS + 2 * S}, c.bid);
             run_gemm(c, XN, (const bf16*)(ws + WS_WKV), S, NKV, D, EpiPlain{UKV, NKV, SS + 2 * S}, rc); } SYNC(11)
    PH(12) { run_gemm(c, ACT, WD(2), S, D, FF, EpiRes{H, H, D, 0.5f, SS + 3 * S, XN}, c.bid); kvpost_phase(c, a, 0, c.bid, c.G); if (c.G != 256) kvpost_phase(c, a, 2, c.bid, c.G); } SYNC(12)
    PH(14) { run_gemm(c, XN, (const bf16*)(ws + WS_WNSA), S, NNSA, D, EpiPlain{UNSA, NNSA, SS + 3 * S}, c.bid);
             const int nfree = (c.G > 64) ? c.G - 32 : c.G, b0 = (c.G > 64) ? c.bid - 32 : c.bid;
             for (int it = b0; it >= 0 && it < 256; it += nfree) { const int w = it >> 7;
                 compress_item(c, (const bf16*)(ws + (w ? WS_VCR : WS_KCR)), (const float*)a.in[w ? 19 : 16], (const bf16*)(ws + WS_W1C + (size_t)w * 128 * 4096 * 2),
                               (const bf16*)(ws + WS_W2C + (size_t)w * 128 * 128 * 2), (bf16*)(ws + (w ? WS_VCC : WS_KCC)), it & 127); }
             if (c.G == 256 && c.bid >= 32) { __syncthreads(); convert_segs(c, a, CV_P14, c.bid - 32, 224); } } SYNC(14)
    PH(15) { for (int it = c.bid; it < 256; it += c.G) nsa_cmp_item(c, a, 63 - (it >> 2), it & 3);
             if (c.G == 256 && c.bid >= 128) kvpost_phase(c, a, 2, c.bid - 128, 128);
             if (c.G == 256) { if (c.bid >= 128) for (int it = 2 * (c.bid - 128); it < 2 * (c.bid - 128) + 2; ++it) mem_item(c, a, UNSA, NNSA, QW, (const bf16*)(ws + WS_MEMKV + (size_t)NMEM * MEMKVW * 2), it >> 2, it & 3); }
             else { for (int it = c.bid; it < 256; it += c.G) mem_item(c, a, UNSA, NNSA, QW, (const bf16*)(ws + WS_MEMKV + (size_t)NMEM * MEMKVW * 2), it >> 2, it & 3); } } SYNC(15)
    PH(16) { const int vb = (c.bid & 7) * 32 + (c.bid >> 3);
             const int k0 = (c.G == 256) ? (int)SW_OFF[vb] : c.bid, k1 = (c.G == 256) ? (int)SW_OFF[vb + 1] : 768, kst = (c.G == 256) ? 1 : c.G;
             for (int k = k0; k < k1; k += kst) { const int i = (c.G == 256) ? (int)SW_TAB[k] : k;
                 nsa_sw_item2(c, a, 63 - i / 12, i % 12); } } SYNC(16)
    PH(17) { run_gemm(c, CAT, (const bf16*)(ws + WS_WOUT + (size_t)D * D * 2), S, D, D, EpiRes{H, H, D, 1.0f, SS + 4 * S, XN}, c.bid); } SYNC(17)
    PH(19) { run_gemm(c, XN, WGU(3), S, NGU, D, EpiSwiGLU{ACT, FF, SS + 4 * S}, c.bid);
             if (c.G == 256 && c.bid >= 128) convert_segs(c, a, CV_P19, c.bid - 128, 128); } SYNC(19)
    PH(20) { run_gemm(c, ACT, WD(3), S, D, FF, EpiRes{H, H, D, 0.5f}, c.bid); } SYNC(20)
    PH(21) { norm_rows(c, H, S, (const float*)a.in[22], nullptr, nullptr, nullptr, a.out); }
#undef PH
#undef SYNC
}

extern "C" void kernel_launch(void* const* d_in, const int* in_sizes, int n_in, void* d_out, int out_size, void* d_ws, size_t ws_size, hipStream_t stream) {
    static int grid = 0;
    if (grid == 0) {
        if (n_in != 23 || out_size != S * D || ws_size < WS_END) { fprintf(stderr, "kernel_launch: unexpected problem (n_in %d, out %d, ws %zu < %zu)\n", n_in, out_size, ws_size, (size_t)WS_END); grid = -1; return; }
        int dev = 0, cus = 0, per_cu = 0;
        hipGetDevice(&dev); hipDeviceGetAttribute(&cus, hipDeviceAttributeMultiprocessorCount, dev);
        if (hipFuncSetAttribute((const void*)fwd_megakernel, hipFuncAttributeMaxDynamicSharedMemorySize, LDS_BYTES) != hipSuccess) { fprintf(stderr, "kernel_launch: hipFuncSetAttribute failed\n"); grid = -1; return; }
        if (hipOccupancyMaxActiveBlocksPerMultiprocessor(&per_cu, (const void*)fwd_megakernel, NTHREADS, LDS_BYTES) != hipSuccess || per_cu < 1) { fprintf(stderr, "kernel_launch: occupancy query gave %d\n", per_cu); per_cu = 1; }
        (void)hipGetLastError();
        grid = cus * per_cu;
    }
    if (grid < 0) return;
    Args a{};
    for (int i = 0; i < 23; ++i) a.in[i] = d_in[i];
    a.out = (float*)d_out; a.ws = (unsigned char*)d_ws;
#if MULTI_LAUNCH
    for (int ph = 0; ph < NPHASES; ++ph) { a.ph_lo = ph; a.ph_hi = ph + 1; hipLaunchKernelGGL(fwd_megakernel, dim3(grid), dim3(NTHREADS), LDS_BYTES, stream, a); }
#else
    a.ph_lo = 0; a.ph_hi = NPHASES;
    if (hipMemsetAsync((unsigned char*)d_ws + WS_CTL, 0, CTL_BYTES, stream) != hipSuccess) { fprintf(stderr, "kernel_launch: memset of the barrier words failed\n"); return; }
    void* args[] = {&a};
    hipError_t e = hipLaunchCooperativeKernel((const void*)fwd_megakernel, dim3(grid), dim3(NTHREADS), args, LDS_BYTES, stream);
    if (e != hipSuccess) fprintf(stderr, "cooperative launch failed: %s (grid %d)\n", hipGetErrorString(e), grid);
#endif
}
```
